# Optimizing an MI355X kernel written in HIP

```python
import jax, jax.numpy as jnp
from jax import lax
import numpy as np

D_MODEL = 1024
BATCH = 32
SEQ = 2048
DEPTH = 1

GRID_W = 64
MIX_WIDTH = D_MODEL
NA_HEADS = 8
NA_HEAD_DIM = 64
NA_WIDTH = NA_HEADS * NA_HEAD_DIM
NA_WIN_R = 8
NA_WIN_C = 16
NA_QCB = 16
NA_KCB = 32
NA_NCB = GRID_W // NA_QCB
HG_HEADS = 4
HG_DK = 128
HG_DV = 128
HG_FDIM = HG_HEADS * HG_DK
HG_WIDTH = HG_HEADS * HG_DV
HG_CHUNK = 64
D_FF = 4 * D_MODEL
RMS_EPS = 1e-6
SPLIT_SIZES = (NA_WIDTH, NA_WIDTH, NA_WIDTH, HG_FDIM, HG_FDIM, HG_FDIM, HG_WIDTH, HG_WIDTH)
D_IN_PROJ = 3 * NA_WIDTH + 3 * HG_FDIM + 2 * HG_WIDTH

kernel_name = "hybrid_natten_hgrn2_encoder_block"


def _rmsnorm(x, w):
    xf = x.astype(jnp.float32)
    y = xf * lax.rsqrt(jnp.mean(xf * xf, axis=-1, keepdims=True) + RMS_EPS)
    return (y * w.astype(jnp.float32)).astype(x.dtype)


def _neighbourhood_attention(qa, ka, va, qn_w, kn_w, rpb, rows):
    B, S, _ = qa.shape
    wr = min(NA_WIN_R, rows)

    def to_grid(t, w):
        t = _rmsnorm(t.reshape(B, S, NA_HEADS, NA_HEAD_DIM).astype(jnp.float32), w) if w is not None \
            else t.reshape(B, S, NA_HEADS, NA_HEAD_DIM).astype(jnp.float32)
        return t.reshape(B, rows, GRID_W, NA_HEADS, NA_HEAD_DIM).transpose(0, 3, 1, 2, 4)

    q = to_grid(qa, qn_w)
    k = to_grid(ka, kn_w)
    v = to_grid(va, None)

    qcol = np.arange(GRID_W).reshape(NA_NCB, NA_QCB)
    band_start = np.clip(np.arange(NA_NCB) * NA_QCB - NA_WIN_C // 2, 0, GRID_W - NA_KCB)
    band_cols = band_start[:, None] + np.arange(NA_KCB)[None, :]
    col_start = np.clip(qcol - NA_WIN_C // 2, 0, GRID_W - NA_WIN_C)
    kc = band_cols[:, None, :]
    col_mask = (kc >= col_start[..., None]) & (kc < col_start[..., None] + NA_WIN_C)
    col_idx = np.clip(kc - qcol[..., None] + NA_WIN_C - 1, 0, 2 * NA_WIN_C - 2)

    k_band = k[:, :, :, band_cols]
    v_band = v[:, :, :, band_cols]
    q_blk = jnp.moveaxis(q.reshape(B, NA_HEADS, rows, NA_NCB, NA_QCB, NA_HEAD_DIM), 2, 0)
    rpb_cols = rpb.astype(jnp.float32)[:, :, col_idx]
    mask = jnp.asarray(col_mask)[:, :, None, :]
    scale = NA_HEAD_DIM ** -0.5

    def row_block(inp):
        r, q_r = inp
        start = jnp.clip(r - wr // 2, 0, rows - wr)
        k_r = lax.dynamic_slice_in_dim(k_band, start, wr, axis=2)
        v_r = lax.dynamic_slice_in_dim(v_band, start, wr, axis=2)
        s = jnp.einsum('bhnqd,bhrnkd->bhnqrk', q_r, k_r) * scale
        ridx = start + jnp.arange(wr, dtype=jnp.int32) - r + NA_WIN_R - 1
        bias = jnp.transpose(rpb_cols[:, ridx], (0, 2, 3, 1, 4))
        s = jnp.where(mask, s + bias, -jnp.inf)
        p = jax.nn.softmax(s, axis=(-2, -1))
        return jnp.einsum('bhnqrk,bhrnkd->bhnqd', p, v_r)

    o = lax.map(row_block, (jnp.arange(rows, dtype=jnp.int32), q_blk))
    o = jnp.moveaxis(o, 0, 2).reshape(B, NA_HEADS, S, NA_HEAD_DIM)
    return o.transpose(0, 2, 1, 3).reshape(B, S, NA_WIDTH)


def _gla_chunk_scan(q, k, log_f, v):
    B, H, S, dk = q.shape
    dv = v.shape[-1]
    n = S // HG_CHUNK

    def chunks(t):
        return jnp.moveaxis(t.reshape(B, H, n, HG_CHUNK, t.shape[-1]), 2, 0)

    qc, kc, vc = chunks(q), chunks(k), chunks(v)
    bc = jnp.cumsum(chunks(log_f), axis=3)
    incl = jnp.tril(jnp.ones((HG_CHUNK, HG_CHUNK), dtype=bool))

    def step(state, inp):
        qi, ki, bi, vi = inp
        o_inter = jnp.einsum('bhid,bhdv->bhiv', qi * jnp.exp(bi), state)
        diff = bi[:, :, :, None, :] - bi[:, :, None, :, :]
        decay = jnp.exp(jnp.where(incl[:, :, None], diff, -jnp.inf))
        a = jnp.einsum('bhid,bhjd,bhijd->bhij', qi, ki, decay)
        o = o_inter + jnp.einsum('bhij,bhjv->bhiv', a, vi)
        b_last = bi[:, :, -1:, :]
        state = jnp.exp(b_last[:, :, 0, :])[..., None] * state + \
            jnp.einsum('bhjd,bhjv->bhdv', ki * jnp.exp(b_last - bi), vi)
        return state, o

    s0 = jnp.zeros((B, H, dk, dv), jnp.float32)
    _, o = lax.scan(step, s0, (qc, kc, bc, vc))
    return jnp.moveaxis(o, 0, 2).reshape(B, H, S, dv)


def _hgrn2_bidirectional(hq, hf_fwd, hf_bwd, hi, hg, lb_f, lb_b, gnorm_w):
    B, S, _ = hq.shape

    def heads(t, d):
        return t.reshape(B, S, HG_HEADS, d).transpose(0, 2, 1, 3)

    q = heads(hq.astype(jnp.float32), HG_DK)
    v = heads(hi.astype(jnp.float32), HG_DV)

    def gate(hf, lb):
        f = lb + (1.0 - lb) * jax.nn.sigmoid(hf.astype(jnp.float32))
        return heads(1.0 - f, HG_DK), heads(jnp.log(f), HG_DK)

    k_f, lf_f = gate(hf_fwd, lb_f)
    k_b, lf_b = gate(hf_bwd, lb_b)
    o_fwd = _gla_chunk_scan(q, k_f, lf_f, v)
    flip = lambda t: jnp.flip(t, axis=2)
    o_bwd = flip(_gla_chunk_scan(flip(q), flip(k_b), flip(lf_b), flip(v)))
    o = (o_fwd + o_bwd).transpose(0, 2, 1, 3)
    g = hg.astype(jnp.float32).reshape(B, S, HG_HEADS, HG_DV)
    o = _rmsnorm(o, gnorm_w) * jax.nn.silu(g)
    return o.reshape(B, S, HG_WIDTH)


def setup_inputs(seed: int = 0) -> dict:
    key = jax.random.key(seed)
    ks = jax.random.split(key, 14)
    f32 = jnp.float32
    nrm = lambda k, shape, s: jax.random.normal(k, shape, f32) * s
    return {
        "x": jax.random.normal(ks[0], (BATCH, SEQ, D_MODEL), f32),
        "w_in": nrm(ks[1], (DEPTH, D_MODEL, D_IN_PROJ), D_MODEL ** -0.5),
        "w_out": nrm(ks[2], (DEPTH, MIX_WIDTH, D_MODEL), MIX_WIDTH ** -0.5),
        "attn_norm_w": 1.0 + nrm(ks[3], (DEPTH, D_MODEL), 0.02),
        "mlp_norm_w": 1.0 + nrm(ks[4], (DEPTH, D_MODEL), 0.02),
        "q_norm_w": 1.0 + nrm(ks[5], (DEPTH, NA_HEAD_DIM), 0.02),
        "k_norm_w": 1.0 + nrm(ks[6], (DEPTH, NA_HEAD_DIM), 0.02),
        "rpb": nrm(ks[7], (DEPTH, NA_HEADS, 2 * NA_WIN_R - 1, 2 * NA_WIN_C - 1), 0.02),
        "hg_norm_w": 1.0 + nrm(ks[8], (DEPTH, HG_DV), 0.02),
        "lb_fwd": 1.0 + nrm(ks[9], (DEPTH + 1, HG_FDIM), 0.1),
        "lb_bwd": 1.0 + nrm(ks[10], (DEPTH + 1, HG_FDIM), 0.1),
        "w_up": nrm(ks[11], (DEPTH, D_MODEL, D_FF), D_MODEL ** -0.5),
        "w_down": nrm(ks[12], (DEPTH, D_FF, D_MODEL), D_FF ** -0.5),
    }


def reference(x, w_in, w_out, attn_norm_w, mlp_norm_w, q_norm_w, k_norm_w, rpb,
              hg_norm_w, lb_fwd, lb_bwd, w_up, w_down):
    B, S, D = x.shape
    rows = S // GRID_W
    split_idx = [int(i) for i in np.cumsum(SPLIT_SIZES)[:-1]]
    lbf_all = jnp.cumsum(jax.nn.softmax(lb_fwd.astype(jnp.float32), axis=0), axis=0)
    lbb_all = jnp.cumsum(jax.nn.softmax(lb_bwd.astype(jnp.float32), axis=0), axis=0)
    h = x
    for layer in range(DEPTH):
        u = _rmsnorm(h, attn_norm_w[layer])
        proj = jnp.einsum('bsd,de->bse', u, w_in[layer])
        qa, ka, va, hq, hff, hfb, hi, hg = jnp.split(proj, split_idx, axis=-1)
        y_na = _neighbourhood_attention(qa, ka, va, q_norm_w[layer], k_norm_w[layer], rpb[layer], rows)
        y_hg = _hgrn2_bidirectional(hq, hff, hfb, hi, hg, lbf_all[layer], lbb_all[layer], hg_norm_w[layer])
        mix = jnp.concatenate([y_na, y_hg], axis=-1).astype(h.dtype)
        h = h + jnp.einsum('bse,ed->bsd', mix, w_out[layer])
        u = _rmsnorm(h, mlp_norm_w[layer])
        a = jnp.square(jax.nn.relu(jnp.einsum('bsd,df->bsf', u, w_up[layer])))
        h = h + jnp.einsum('bsf,fd->bsd', a, w_down[layer])
    return h
```

```cpp
#include <hip/hip_runtime.h>
#include <hip/hip_cooperative_groups.h>
#include <cstdio>
#include <cstdint>
namespace cg = cooperative_groups;

#define LAS __attribute__((address_space(3)))
typedef unsigned short bf16_t;
typedef short bf16x8 __attribute__((ext_vector_type(8)));
typedef float f32x4 __attribute__((ext_vector_type(4)));
typedef float f32x2 __attribute__((ext_vector_type(2)));
typedef unsigned u32x4 __attribute__((ext_vector_type(4)));
typedef unsigned u32x2 __attribute__((ext_vector_type(2)));

constexpr int BATCH = 32, SEQ = 2048, DM = 1024, MROWS = BATCH * SEQ, DIN = 4096, FF = 4096;
constexpr float RMS_EPS = 1e-6f;
constexpr float LOG2E = 1.4426950408889634f;
constexpr int NTHREADS = 512, NWAVES = 8;
constexpr int LDS_BYTES = 155648;

constexpr size_t MiB = 1u << 20;
constexpr size_t WS_WIN = 2 * MiB, WS_WOUT = 10 * MiB, WS_WUP = 12 * MiB, WS_WDN = 20 * MiB, WS_PART = 28 * MiB;
constexpr size_t WS_U = 32 * MiB;
constexpr size_t WS_MIX = 160 * MiB;
constexpr size_t WS_PROJ = 288 * MiB;
constexpr size_t WS_OPART = 800 * MiB;
constexpr size_t WS_END = 928 * MiB;

typedef __bf16 hwbf16x2 __attribute__((ext_vector_type(2)));
__device__ __forceinline__ unsigned cvt_pk_bf16(float lo, float hi) { const f32x2 v = {lo, hi}; const hwbf16x2 b = __builtin_convertvector(v, hwbf16x2); return __builtin_bit_cast(unsigned, b); }
__device__ __forceinline__ float bf2f(unsigned short v) { return __uint_as_float(((unsigned)v) << 16); }
__device__ __forceinline__ float bflo(unsigned w) { return __uint_as_float(w << 16); }
__device__ __forceinline__ float bfhi(unsigned w) { return __uint_as_float(w & 0xffff0000u); }
__device__ __forceinline__ float wave_sum(float v) {
#pragma unroll
    for (int o = 1; o < 64; o <<= 1) v += __shfl_xor(v, o);
    return v;
}
__device__ __forceinline__ float wave_max(float v) {
#pragma unroll
    for (int o = 1; o < 64; o <<= 1) v = fmaxf(v, __shfl_xor(v, o));
    return v;
}

namespace pg8 {
#define PG8_LAS __attribute__((address_space(3)))
constexpr int BM = 256, BK = 64, HALF = 128, HTB = HALF * BK * 2, STAGE_BYTES = 8 * HTB, NXCD = 8, WGM = 8;

__host__ __device__ __forceinline__ int lds_byte(int r, int c) { const int st = (r >> 4) * 2 + (c >> 5), rr = r & 15, cc = c & 31, ob = rr * 64 + cc * 2; return st * 1024 + (ob ^ (((ob >> 9) & 1) << 5)); }
__host__ __device__ __forceinline__ void stage_rc(int b, int& R, int& C) { const int st = b / 1024, sb = b % 1024, swz = sb ^ (((sb >> 9) & 1) << 5); R = (st >> 1) * 16 + swz / 64; C = (st & 1) * 32 + (swz % 64) / 2; }
__host__ __device__ __forceinline__ int perm32(int rho) { const int n = rho >> 4, i = rho & 15; return 8 * (i >> 2) + 4 * n + (i & 3); }

struct Unit { int pm, pn; };
struct Gemm { const bf16_t* A; const bf16_t* Bt; int M, N, K; };

struct StaticOrder {
    int nM, nN, nwg, G, c;
    __host__ __device__ void init(int M, int N, int G_, int c_) { nM = M / BM; nN = N / BM; nwg = nM * nN; G = G_; c = c_; }
    __host__ __device__ bool next(int i, Unit& u) const {
        const long L = (long)i * G + c; if (L >= nwg) return false;
        int wgid = (int)L; { const int q = nwg / NXCD, r = nwg % NXCD, xcd = wgid % NXCD, off = wgid / NXCD; wgid = (xcd < r ? xcd * (q + 1) : r * (q + 1) + (xcd - r) * q) + off; }
        const int nig = WGM * nN, gid = wgid / nig, fm = gid * WGM, gsz = (nM - fm) < WGM ? (nM - fm) : WGM;
        u.pm = fm + ((wgid % nig) % gsz); u.pn = (wgid % nig) / gsz; return true;
    }
    __device__ __forceinline__ void a_ready(const Unit&) const {}
    __device__ __forceinline__ void done(const Unit&) const {}
};

struct EpiBf16 {
    static constexpr bool PERM = true, AFTER_DRAIN = false;
    bf16_t* O; int ldc;
    __device__ __forceinline__ void operator()(const f32x4 (&acc)[2][2][4][2], const Unit& u, int wr, int wc, int fr, int fq) const {
        const int row0 = u.pm * BM + wr * 64 + fr; const int col0 = u.pn * BM + wc * 32 + 8 * fq;
#pragma unroll
        for (int ai = 0; ai < 2; ++ai)
#pragma unroll
            for (int m = 0; m < 4; ++m) { bf16_t* rowp = O + (size_t)(row0 + ai * HALF + m * 16) * ldc + col0;
#pragma unroll
                for (int bj = 0; bj < 2; ++bj) { const f32x4 v0 = acc[ai][bj][m][0], v1 = acc[ai][bj][m][1];
                    u32x4 w; w.x = cvt_pk_bf16(v0[0], v0[1]); w.y = cvt_pk_bf16(v0[2], v0[3]); w.z = cvt_pk_bf16(v1[0], v1[1]); w.w = cvt_pk_bf16(v1[2], v1[3]);
                    *(u32x4*)(rowp + bj * HALF) = w; } }
    }
};
struct EpiUp {
    static constexpr bool PERM = true, AFTER_DRAIN = false;
    bf16_t* O; int ldc; const float* part;
    __device__ __forceinline__ void operator()(const f32x4 (&acc)[2][2][4][2], const Unit& u, int wr, int wc, int fr, int fq) const {
        const int row0 = u.pm * BM + wr * 64 + fr; const int col0 = u.pn * BM + wc * 32 + 8 * fq;
#pragma unroll
        for (int ai = 0; ai < 2; ++ai)
#pragma unroll
            for (int m = 0; m < 4; ++m) { const int row = row0 + ai * HALF + m * 16; bf16_t* rowp = O + (size_t)row * ldc + col0;
                const f32x4* pp = (const f32x4*)(part + (size_t)row * 16); const f32x4 s4 = (pp[0] + pp[1]) + (pp[2] + pp[3]);
                const float rs = rsqrtf(((s4[0] + s4[1]) + (s4[2] + s4[3])) * (1.0f / DM) + RMS_EPS);
#pragma unroll
                for (int bj = 0; bj < 2; ++bj) { f32x4 v0 = acc[ai][bj][m][0] * rs, v1 = acc[ai][bj][m][1] * rs;
#pragma unroll
                    for (int e = 0; e < 4; ++e) { const float a = fmaxf(v0[e], 0.f), b = fmaxf(v1[e], 0.f); v0[e] = a * a; v1[e] = b * b; }
                    u32x4 w; w.x = cvt_pk_bf16(v0[0], v0[1]); w.y = cvt_pk_bf16(v0[2], v0[3]); w.z = cvt_pk_bf16(v1[0], v1[1]); w.w = cvt_pk_bf16(v1[2], v1[3]);
                    *(u32x4*)(rowp + bj * HALF) = w; } }
    }
};
struct EpiResid {
    static constexpr bool PERM = false, AFTER_DRAIN = false;
    const float* x; float* out; bf16_t* hb; float* part;
    __device__ __forceinline__ void operator()(const f32x4 (&acc)[2][2][4][2], const Unit& u, int wr, int wc, int fr, int fq) const {
        const int col0 = u.pn * BM + wc * 32 + 4 * fq;
#pragma unroll
        for (int ai = 0; ai < 2; ++ai)
#pragma unroll
            for (int m = 0; m < 4; ++m) { const int row = u.pm * BM + ai * HALF + wr * 64 + m * 16 + fr; const size_t off = (size_t)row * DM + col0; float ss = 0.f;
#pragma unroll
                for (int bj = 0; bj < 2; ++bj)
#pragma unroll
                    for (int n = 0; n < 2; ++n) { const size_t c = off + bj * HALF + n * 16; const f32x4 hv = *(const f32x4*)(x + c) + acc[ai][bj][m][n];
                        *(f32x4*)(out + c) = hv; ss += (hv[0] * hv[0] + hv[1] * hv[1]) + (hv[2] * hv[2] + hv[3] * hv[3]);
                        u32x2 w; w.x = cvt_pk_bf16(hv[0], hv[1]); w.y = cvt_pk_bf16(hv[2], hv[3]); *(u32x2*)(hb + c) = w; }
                ss += __shfl_xor(ss, 16); ss += __shfl_xor(ss, 32);
                if (fq == 0) part[(size_t)row * 16 + u.pn * 4 + wc] = ss; }
    }
};
struct EpiDown {
    static constexpr bool PERM = false, AFTER_DRAIN = false;
    float* out;
    __device__ __forceinline__ void operator()(const f32x4 (&acc)[2][2][4][2], const Unit& u, int wr, int wc, int fr, int fq) const {
        const int col0 = u.pn * BM + wc * 32 + 4 * fq;
#pragma unroll
        for (int ai = 0; ai < 2; ++ai)
#pragma unroll
            for (int m = 0; m < 4; ++m) { const int row = u.pm * BM + ai * HALF + wr * 64 + m * 16 + fr; const size_t off = (size_t)row * DM + col0;
#pragma unroll
                for (int bj = 0; bj < 2; ++bj)
#pragma unroll
                    for (int n = 0; n < 2; ++n) { const size_t c = off + bj * HALF + n * 16; *(f32x4*)(out + c) = *(const f32x4*)(out + c) + acc[ai][bj][m][n]; } }
    }
};

template <class Epi, class Sched, bool ALIGN_EPI = false, bool SP2 = false>
__device__ __forceinline__ void gemm_phase(PG8_LAS unsigned char* lds, const Gemm g, const Sched& S, const Epi& E) {
    const int tid = threadIdx.x, wid = __builtin_amdgcn_readfirstlane(tid >> 6), lane = tid & 63, wr = wid >> 2, wc = wid & 3, fr = lane & 15, fq = lane >> 4;
    const int K = g.K, nt = K / BK;
    unsigned voffA[2], voffB[2];
#pragma unroll
    for (int i = 0; i < 2; ++i) { int R, C; stage_rc(tid * 16 + i * 8192, R, C); const int Rb = Epi::PERM ? ((R & ~31) + perm32(R & 31)) : R;
        voffA[i] = (unsigned)(R * K + C) * 2u; voffB[i] = (unsigned)(Rb * K + C) * 2u; }
    const size_t kstep = (size_t)(BK * 2);
    const size_t hstep = (size_t)HALF * K * 2;
    const size_t tstep = 2 * hstep;
    const unsigned ldsw = (unsigned)wid * 1024u;
    const int aoff = lds_byte(wr * 64 + fr, fq * 8), boff = lds_byte(wc * 32 + fr, fq * 8);
#define PG8_SA(b, h) (((b) * 2 + (h)) * HTB)
#define PG8_SB(b, h) ((4 + (b) * 2 + (h)) * HTB)
#define PG8_STAGE(bufoff, gbase, voff) do { _Pragma("unroll") for (int _i = 0; _i < 2; ++_i) \
        __builtin_amdgcn_global_load_lds((const unsigned*)((const char*)(gbase) + (voff)[_i]), (PG8_LAS unsigned*)(lds + (bufoff) + ldsw + _i * 8192), 16, 0, 0); } while (0)
#define PG8_LDA(dst, b, h) do { _Pragma("unroll") for (int m = 0; m < 4; ++m) _Pragma("unroll") for (int k = 0; k < 2; ++k) dst[m][k] = *(const PG8_LAS bf16x8*)(lds + PG8_SA(b, h) + aoff + m * 2048 + k * 1024); } while (0)
#define PG8_LDB(dst, b, h) do { _Pragma("unroll") for (int n = 0; n < 2; ++n) _Pragma("unroll") for (int k = 0; k < 2; ++k) dst[n][k] = *(const PG8_LAS bf16x8*)(lds + PG8_SB(b, h) + boff + n * 2048 + k * 1024); } while (0)
#define PG8_MMA(ai, bj, At, Bt) do { __builtin_amdgcn_s_setprio(1); _Pragma("unroll") for (int m = 0; m < 4; ++m) _Pragma("unroll") for (int n = 0; n < 2; ++n) _Pragma("unroll") for (int k = 0; k < 2; ++k) \
        acc[ai][bj][m][n] = __builtin_amdgcn_mfma_f32_16x16x32_bf16(Bt[n][k], At[m][k], acc[ai][bj][m][n], 0, 0, 0); __builtin_amdgcn_s_setprio(0); } while (0)
#define PG8_WAIT_V(n) asm volatile("s_waitcnt vmcnt(" #n ")" ::: "memory")
#define PG8_WAIT_L(n) asm volatile("s_waitcnt lgkmcnt(" #n ")" ::: "memory")
#define PG8_BAR __builtin_amdgcn_s_barrier()
#define PG8_SCHED __builtin_amdgcn_sched_barrier(0)
    Unit cur, nxt; int ui = 0;
    if (!S.next(0, cur)) return;
    f32x4 acc[2][2][4][2];
#pragma unroll
    for (int a = 0; a < 2; ++a)
#pragma unroll
        for (int b = 0; b < 2; ++b)
#pragma unroll
            for (int m = 0; m < 4; ++m)
#pragma unroll
                for (int n = 0; n < 2; ++n) acc[a][b][m][n] = (f32x4){0.f, 0.f, 0.f, 0.f};
    bf16x8 At[4][2], B0[2][2], B1[2][2];
    const char* cA = (const char*)g.A + (size_t)cur.pm * tstep; const char* cB = (const char*)g.Bt + (size_t)cur.pn * tstep;
    S.a_ready(cur);
    if constexpr (SP2) {
        PG8_STAGE(PG8_SB(0, 0), cB, voffB); PG8_STAGE(PG8_SB(0, 1), cB + hstep, voffB); PG8_STAGE(PG8_SA(0, 0), cA, voffA); PG8_STAGE(PG8_SA(0, 1), cA + hstep, voffA);
        if (wr == 1) PG8_BAR;
        PG8_WAIT_V(2); PG8_BAR;
        PG8_STAGE(PG8_SB(1, 0), cB + kstep, voffB); PG8_STAGE(PG8_SA(1, 0), cA + kstep, voffA); PG8_STAGE(PG8_SB(1, 1), cB + hstep + kstep, voffB);
        PG8_WAIT_V(6); PG8_BAR;
    } else {
        PG8_STAGE(PG8_SB(0, 0), cB, voffB); PG8_STAGE(PG8_SA(0, 0), cA, voffA); PG8_STAGE(PG8_SB(0, 1), cB + hstep, voffB); PG8_STAGE(PG8_SA(0, 1), cA + hstep, voffA);
        if (wr == 1) PG8_BAR;
        PG8_WAIT_V(4); PG8_BAR;
        PG8_STAGE(PG8_SB(1, 0), cB + kstep, voffB); PG8_STAGE(PG8_SA(1, 0), cA + kstep, voffA); PG8_STAGE(PG8_SB(1, 1), cB + hstep + kstep, voffB);
        PG8_WAIT_V(6); PG8_BAR;
    }
    for (;;) {
        const bool has_next = S.next(ui + 1, nxt);
        const char* nA = has_next ? (const char*)g.A + (size_t)nxt.pm * tstep : cA; const char* nB = has_next ? (const char*)g.Bt + (size_t)nxt.pn * tstep : cB;
        for (int t = 0; t < nt; t += 2) {
            const bool last = (t == nt - 2);
            const char* a1 = cA + (size_t)(t + 1) * kstep;
            const char* a2 = last ? nA : cA + (size_t)(t + 2) * kstep; const char* b2 = last ? nB : cB + (size_t)(t + 2) * kstep;
            const char* a3 = a2 + kstep; const char* b3 = b2 + kstep;
            if (last && has_next) S.a_ready(nxt);
            if constexpr (SP2) {
            PG8_LDB(B0, 0, 0); PG8_LDB(B1, 0, 1); PG8_SCHED; PG8_LDA(At, 0, 0); PG8_STAGE(PG8_SA(1, 1), a1 + hstep, voffA);
            PG8_WAIT_V(8); PG8_WAIT_L(0); PG8_BAR; PG8_MMA(0, 0, At, B0); PG8_MMA(0, 1, At, B1); PG8_BAR; PG8_SCHED;
            PG8_LDA(At, 0, 1); PG8_STAGE(PG8_SB(0, 0), b2, voffB); PG8_STAGE(PG8_SB(0, 1), b2 + hstep, voffB); PG8_STAGE(PG8_SA(0, 0), a2, voffA);
            PG8_WAIT_V(8); PG8_WAIT_L(0); PG8_BAR; PG8_MMA(1, 0, At, B0); PG8_MMA(1, 1, At, B1); PG8_BAR; PG8_SCHED;
            PG8_LDB(B0, 1, 0); PG8_LDB(B1, 1, 1); PG8_SCHED; PG8_LDA(At, 1, 0); PG8_STAGE(PG8_SA(0, 1), a2 + hstep, voffA);
            PG8_WAIT_V(8); PG8_WAIT_L(0); PG8_BAR; PG8_MMA(0, 0, At, B0); PG8_MMA(0, 1, At, B1); PG8_BAR; PG8_SCHED;
            PG8_LDA(At, 1, 1); PG8_STAGE(PG8_SB(1, 0), b3, voffB); PG8_STAGE(PG8_SB(1, 1), b3 + hstep, voffB); PG8_STAGE(PG8_SA(1, 0), a3, voffA);
            PG8_WAIT_V(8); PG8_WAIT_L(0); PG8_BAR; PG8_MMA(1, 0, At, B0); PG8_MMA(1, 1, At, B1); PG8_BAR; PG8_SCHED;
            } else {
            PG8_LDB(B0, 0, 0); PG8_SCHED; PG8_LDA(At, 0, 0); PG8_STAGE(PG8_SA(1, 1), a1 + hstep, voffA);
            PG8_WAIT_L(8); PG8_BAR; PG8_WAIT_L(0); PG8_MMA(0, 0, At, B0); PG8_BAR; PG8_SCHED;
            PG8_LDB(B1, 0, 1); PG8_STAGE(PG8_SB(0, 0), b2, voffB);
            PG8_BAR; PG8_WAIT_L(0); PG8_MMA(0, 1, At, B1); PG8_BAR;
            PG8_LDA(At, 0, 1); PG8_STAGE(PG8_SA(0, 0), a2, voffA);
            PG8_BAR; PG8_WAIT_L(0); PG8_MMA(1, 0, At, B0); PG8_BAR; PG8_SCHED;
            PG8_STAGE(PG8_SB(0, 1), b2 + hstep, voffB);
            PG8_WAIT_V(6); PG8_BAR; PG8_MMA(1, 1, At, B1); PG8_BAR;
            PG8_LDB(B0, 1, 0); PG8_SCHED; PG8_LDA(At, 1, 0); PG8_STAGE(PG8_SA(0, 1), a2 + hstep, voffA);
            PG8_WAIT_L(8); PG8_BAR; PG8_WAIT_L(0); PG8_MMA(0, 0, At, B0); PG8_BAR; PG8_SCHED;
            PG8_LDB(B1, 1, 1); PG8_STAGE(PG8_SB(1, 0), b3, voffB);
            PG8_BAR; PG8_WAIT_L(0); PG8_MMA(0, 1, At, B1); PG8_BAR;
            PG8_LDA(At, 1, 1); PG8_STAGE(PG8_SA(1, 0), a3, voffA);
            PG8_BAR; PG8_WAIT_L(0); PG8_MMA(1, 0, At, B0); PG8_BAR; PG8_SCHED;
            PG8_STAGE(PG8_SB(1, 1), b3 + hstep, voffB);
            PG8_WAIT_V(6); PG8_BAR; PG8_MMA(1, 1, At, B1); PG8_BAR;
            }
        }
        if constexpr (ALIGN_EPI) { if (wr == 0) PG8_BAR; }
        if constexpr (!Epi::AFTER_DRAIN) { E(acc, cur, wr, wc, fr, fq); S.done(cur); }
        if (!has_next) break;
#pragma unroll
        for (int a = 0; a < 2; ++a)
#pragma unroll
            for (int b = 0; b < 2; ++b)
#pragma unroll
                for (int m = 0; m < 4; ++m)
#pragma unroll
                    for (int n = 0; n < 2; ++n) acc[a][b][m][n] = (f32x4){0.f, 0.f, 0.f, 0.f};
        cur = nxt; cA = nA; cB = nB; ++ui;
        if constexpr (ALIGN_EPI) { if (wr == 1) PG8_BAR; }
    }
    PG8_WAIT_V(0);
    if constexpr (!ALIGN_EPI) { if (wr == 0) PG8_BAR; }
    PG8_BAR;
#undef PG8_SA
#undef PG8_SB
#undef PG8_STAGE
#undef PG8_LDA
#undef PG8_LDB
#undef PG8_MMA
#undef PG8_WAIT_V
#undef PG8_WAIT_L
#undef PG8_BAR
#undef PG8_SCHED
}
}

struct Params {
    const float *x, *w_in, *w_out, *anw, *mnw, *qnw, *knw, *rpb, *hgw, *lbf, *lbb, *w_up, *w_dn;
    float* out; unsigned char* ws;
};

__device__ __forceinline__ void p0_transpose_item(const float* W, int K, int N, bf16_t* WT, const float* scale, LAS float* scr, int item, int lane) {
    const int nblk = N / 32, kb = item / nblk, nb = item % nblk, k0 = 64 * kb, n0 = 32 * nb;
#pragma unroll 8
    for (int i = 0; i < 32; ++i) { const int kk = 2 * i + (lane >> 5); float v = W[(size_t)(k0 + kk) * N + n0 + (lane & 31)]; if (scale) v *= scale[k0 + kk]; scr[kk * 33 + (lane & 31)] = v; }
    asm volatile("s_waitcnt lgkmcnt(0)" ::: "memory");
    const int c = lane & 7;
#pragma unroll
    for (int j = 0; j < 4; ++j) { const int n = (lane >> 3) + 8 * j; const LAS float* s = scr + (8 * c) * 33 + n;
        u32x4 o; o.x = cvt_pk_bf16(s[0 * 33], s[1 * 33]); o.y = cvt_pk_bf16(s[2 * 33], s[3 * 33]); o.z = cvt_pk_bf16(s[4 * 33], s[5 * 33]); o.w = cvt_pk_bf16(s[6 * 33], s[7 * 33]);
        *(u32x4*)(WT + (size_t)(n0 + n) * K + k0 + 8 * c) = o; }
    asm volatile("s_waitcnt lgkmcnt(0)" ::: "memory");
}
__device__ __forceinline__ void rms_row_to_bf16(const float* xrow, const f32x4 (&wv)[4], bf16_t* orow, int lane) {
    const f32x4* xr = (const f32x4*)xrow + lane;
    f32x4 v[4]; float s = 0.f;
#pragma unroll
    for (int j = 0; j < 4; ++j) { v[j] = xr[64 * j]; s += (v[j].x * v[j].x + v[j].y * v[j].y) + (v[j].z * v[j].z + v[j].w * v[j].w); }
    const float rstd = rsqrtf(wave_sum(s) * (1.f / DM) + RMS_EPS);
    u32x2* o8 = (u32x2*)orow + lane;
#pragma unroll
    for (int j = 0; j < 4; ++j) { const f32x4 y = v[j] * rstd * wv[j]; u32x2 w; w.x = cvt_pk_bf16(y.x, y.y); w.y = cvt_pk_bf16(y.z, y.w); o8[64 * j] = w; }
}

namespace na {
constexpr int KR_OFF = 0;
constexpr int VT_OFF = 65536;
constexpr int VT_SLOT = 64 * 136;
constexpr int RPB_OFF = VT_OFF + 8 * VT_SLOT;
constexpr int MRG_OFF = RPB_OFF + 2048;
constexpr int END = MRG_OFF + 17408;
static_assert(END <= LDS_BYTES, "na lds");

__device__ __forceinline__ void na_item(LAS unsigned char* lds, const Params& p, const bf16_t* PROJ, bf16_t* MIX, int b, int h) {
    const int tid = threadIdx.x, w = __builtin_amdgcn_readfirstlane(tid >> 6), l = tid & 63;
    const int n = w & 3, half = w >> 2, q16 = l & 15, g = l >> 4;
    LAS float* RPB = (LAS float*)(lds + RPB_OFF);
    const float mq = wave_max(fabsf(p.qnw[l])), mk = wave_max(fabsf(p.knw[l]));
    float mr = 0.f;
    for (int i = l; i < 465; i += 64) mr = fmaxf(mr, fabsf(p.rpb[h * 465 + i]));
    mr = wave_max(mr);
    for (int i = tid; i < 465; i += NTHREADS) RPB[i] = p.rpb[h * 465 + i] * LOG2E;
    const float Mshift = (64.f * mq * mk * 0.125f + mr) * LOG2E;
    float qsw[2][8];
#pragma unroll
    for (int ks = 0; ks < 2; ++ks)
#pragma unroll
        for (int j = 0; j < 8; ++j) qsw[ks][j] = p.qnw[8 * g + 32 * ks + j] * (0.125f * LOG2E);
    const int lc = tid >> 3, ldg = tid & 7;
    float knw[8];
#pragma unroll
    for (int j = 0; j < 8; ++j) knw[j] = p.knw[ldg * 8 + j];
    const int lsw = (lc ^ (lc >> 3)) & 7;
    __syncthreads();
    const int c = 16 * n + q16;
    const int cs = min(max(c - 8, 0), 48), bs = min(max(16 * n - 8, 0), 32);
    int nl = 0;
    for (int r = 0; r < 32; ++r) {
        const int start = min(max(r - 4, 0), 24);
        while (nl < start + 8) {
            const int slot = nl & 7;
            const bf16_t* gp = PROJ + (size_t)(b * SEQ + nl * 64 + lc) * DIN + 512 + h * 64 + ldg * 8;
            const u32x4 kv = *(const u32x4*)gp, vv = *(const u32x4*)(gp + 512);
            float kf[8];
#pragma unroll
            for (int j = 0; j < 4; ++j) { kf[2 * j] = bflo(kv[j]); kf[2 * j + 1] = bfhi(kv[j]); }
            float ss = 0.f;
#pragma unroll
            for (int j = 0; j < 8; ++j) ss += kf[j] * kf[j];
            ss += __shfl_xor(ss, 1); ss += __shfl_xor(ss, 2); ss += __shfl_xor(ss, 4);
            const float rstd = rsqrtf(ss * (1.f / 64.f) + RMS_EPS);
            u32x4 ko;
#pragma unroll
            for (int j = 0; j < 4; ++j) ko[j] = cvt_pk_bf16(kf[2 * j] * rstd * knw[2 * j], kf[2 * j + 1] * rstd * knw[2 * j + 1]);
            *(LAS u32x4*)(lds + KR_OFF + slot * 8192 + lc * 128 + ((ldg ^ lsw) << 4)) = ko;
            LAS unsigned char* vb = lds + VT_OFF + slot * VT_SLOT + (ldg * 8) * 136 + lc * 2;
#pragma unroll
            for (int j = 0; j < 4; ++j) { *(LAS unsigned short*)(vb + (2 * j) * 136) = (unsigned short)(vv[j] & 0xffffu); *(LAS unsigned short*)(vb + (2 * j + 1) * 136) = (unsigned short)(vv[j] >> 16); }
            ++nl;
        }
        bf16x8 bq[2];
        {
            const bf16_t* qp = PROJ + (size_t)(b * SEQ + r * 64 + c) * DIN + h * 64 + 8 * g;
            const u32x4 q0 = *(const u32x4*)qp, q1 = *(const u32x4*)(qp + 32);
            float qf[2][8];
#pragma unroll
            for (int j = 0; j < 4; ++j) { qf[0][2 * j] = bflo(q0[j]); qf[0][2 * j + 1] = bfhi(q0[j]); qf[1][2 * j] = bflo(q1[j]); qf[1][2 * j + 1] = bfhi(q1[j]); }
            float ss = 0.f;
#pragma unroll
            for (int j = 0; j < 8; ++j) ss += qf[0][j] * qf[0][j] + qf[1][j] * qf[1][j];
            ss += __shfl_xor(ss, 16); ss += __shfl_xor(ss, 32);
            const float rstd = rsqrtf(ss * (1.f / 64.f) + RMS_EPS);
#pragma unroll
            for (int ks = 0; ks < 2; ++ks) { u32x4 t;
#pragma unroll
                for (int j = 0; j < 4; ++j) t[j] = cvt_pk_bf16(qf[ks][2 * j] * rstd * qsw[ks][2 * j], qf[ks][2 * j + 1] * rstd * qsw[ks][2 * j + 1]);
                bq[ks] = __builtin_bit_cast(bf16x8, t); }
        }
        __syncthreads();
        f32x4 o[4];
#pragma unroll
        for (int dt = 0; dt < 4; ++dt) o[dt] = (f32x4){0.f, 0.f, 0.f, 0.f};
        float lsum = 0.f;
#pragma unroll
        for (int krl = 0; krl < 4; ++krl) {
            const int R = start + 4 * half + krl, slot = R & 7, ridx = R - r + 7;
            const LAS unsigned char* kbase = lds + KR_OFF + slot * 8192;
            f32x4 s[2];
#pragma unroll
            for (int ct = 0; ct < 2; ++ct) {
                const int kcol = bs + 16 * ct + q16, sw = (kcol ^ (kcol >> 3)) & 7;
                const bf16x8 a0 = *(const LAS bf16x8*)(kbase + kcol * 128 + ((g ^ sw) << 4));
                const bf16x8 a1 = *(const LAS bf16x8*)(kbase + kcol * 128 + (((g + 4) ^ sw) << 4));
                f32x4 acc = (f32x4){0.f, 0.f, 0.f, 0.f};
                acc = __builtin_amdgcn_mfma_f32_16x16x32_bf16(a0, bq[0], acc, 0, 0, 0);
                acc = __builtin_amdgcn_mfma_f32_16x16x32_bf16(a1, bq[1], acc, 0, 0, 0);
                s[ct] = acc;
            }
            float pv[2][4];
#pragma unroll
            for (int ct = 0; ct < 2; ++ct)
#pragma unroll
                for (int i = 0; i < 4; ++i) {
                    const int kc = bs + 16 * ct + 4 * g + i; const bool valid = (unsigned)(kc - cs) < 16u;
                    const int idx = valid ? (ridx * 31 + (kc - c + 15)) : 0;
                    const float bias = RPB[idx];
                    const float e = __builtin_amdgcn_exp2f(s[ct][i] + bias - Mshift);
                    pv[ct][i] = valid ? e : 0.f; lsum += pv[ct][i];
                }
            u32x4 pw; pw.x = cvt_pk_bf16(pv[0][0], pv[0][1]); pw.y = cvt_pk_bf16(pv[0][2], pv[0][3]); pw.z = cvt_pk_bf16(pv[1][0], pv[1][1]); pw.w = cvt_pk_bf16(pv[1][2], pv[1][3]);
            const bf16x8 pb = __builtin_bit_cast(bf16x8, pw);
            const LAS unsigned char* vbase = lds + VT_OFF + slot * VT_SLOT + (bs + 4 * g) * 2;
#pragma unroll
            for (int dt = 0; dt < 4; ++dt) {
                const LAS unsigned char* va = vbase + (16 * dt + q16) * 136;
                const u32x2 lo = *(const LAS u32x2*)va, hi = *(const LAS u32x2*)(va + 32);
                u32x4 t; t.x = lo.x; t.y = lo.y; t.z = hi.x; t.w = hi.y;
                o[dt] = __builtin_amdgcn_mfma_f32_16x16x32_bf16(__builtin_bit_cast(bf16x8, t), pb, o[dt], 0, 0, 0);
            }
        }
        lsum += __shfl_xor(lsum, 16); lsum += __shfl_xor(lsum, 32);
        LAS float* mg = (LAS float*)(lds + MRG_OFF) + ((w & 3) * 64 + l) * 17;
        if (half == 1) {
#pragma unroll
            for (int dt = 0; dt < 4; ++dt)
#pragma unroll
                for (int i = 0; i < 4; ++i) mg[dt * 4 + i] = o[dt][i];
            mg[16] = lsum;
        }
        __syncthreads();
        if (half == 0) {
            const float inv = 1.0f / (lsum + mg[16]);
            bf16_t* op = MIX + (size_t)(b * SEQ + r * 64 + c) * DM + h * 64 + 4 * g;
#pragma unroll
            for (int dt = 0; dt < 4; ++dt) { u32x2 wv; wv.x = cvt_pk_bf16((o[dt][0] + mg[dt * 4 + 0]) * inv, (o[dt][1] + mg[dt * 4 + 1]) * inv);
                wv.y = cvt_pk_bf16((o[dt][2] + mg[dt * 4 + 2]) * inv, (o[dt][3] + mg[dt * 4 + 3]) * inv); *(u32x2*)(op + 16 * dt) = wv; }
        }
    }
    __syncthreads();
}
}

namespace hg {
constexpr int ST_OFF = 0;
constexpr int ST_DIR = 128 * 272;
constexpr int QB_OFF = 2 * ST_DIR;
constexpr int KB_OFF = QB_OFF + 17408;
constexpr int K2_OFF = KB_OFF + 17408;
constexpr int VT_OFF = K2_OFF + 18432;
constexpr int PT_OFF = VT_OFF + 18432;
constexpr int PL_OFF = PT_OFF + 2048;
constexpr int SS_OFF = PL_OFF + 512;
constexpr int END = SS_OFF + 512;
static_assert(END <= LDS_BYTES, "hg lds");

template <int DIR>
__device__ __forceinline__ void hg_step(LAS unsigned char* lds, const Params& p, const bf16_t* PROJ, bf16_t* MIX, float* OPART, int b, int h4, int ch, bool fin, float lb, f32x4 (&S)[8]) {
    const int tid = threadIdx.x, w = __builtin_amdgcn_readfirstlane(tid >> 6), l = tid & 63, q16 = l & 15, g = l >> 4;
    const size_t tok0 = (size_t)b * SEQ + (size_t)ch * 64;
    const int d = tid & 127, tq = tid >> 7;
    LAS float* PT = (LAS float*)(lds + PT_OFF); LAS float* PL = (LAS float*)(lds + PL_OFF); LAS float* SSx = (LAS float*)(lds + SS_OFF);
    float f[16], qv[16];
    {
        const bf16_t* base = PROJ + (tok0 + 16 * tq) * DIN + h4 * 128 + d;
        const bf16_t* hfp = base + (DIR ? 2560 : 2048); const bf16_t* qp = base + 1536; const bf16_t* vp = base + 3072;
        unsigned short hraw[16], vraw[16];
#pragma unroll
        for (int i = 0; i < 16; ++i) { hraw[i] = hfp[(size_t)i * DIN]; qv[i] = bf2f(qp[(size_t)i * DIN]); vraw[i] = vp[(size_t)i * DIN]; }
        float tot = 1.f;
#pragma unroll
        for (int i = 0; i < 16; ++i) { const float e = __builtin_amdgcn_exp2f(-bf2f(hraw[i]) * LOG2E); const float r = __builtin_amdgcn_rcpf(1.f + e); f[i] = lb + (1.f - lb) * r; tot *= f[i]; }
        PT[tq * 128 + d] = tot;
        u32x4 v0, v1;
#pragma unroll
        for (int j = 0; j < 4; ++j) { v0[j] = (unsigned)vraw[2 * j] | ((unsigned)vraw[2 * j + 1] << 16); v1[j] = (unsigned)vraw[8 + 2 * j] | ((unsigned)vraw[9 + 2 * j] << 16); }
        LAS unsigned char* vt = lds + VT_OFF + d * 144 + tq * 32;
        *(LAS u32x4*)vt = v0; *(LAS u32x4*)(vt + 16) = v1;
    }
    __syncthreads();
    {
        const float p0 = PT[d], p1 = PT[128 + d], p2 = PT[256 + d], p3 = PT[384 + d];
        const float plast = (p0 * p1) * (p2 * p3);
        float Pc;
        if (!DIR) Pc = tq == 0 ? 1.f : (tq == 1 ? p0 : (tq == 2 ? p0 * p1 : p0 * p1 * p2));
        else      Pc = tq == 3 ? 1.f : (tq == 2 ? p3 : (tq == 1 ? p3 * p2 : p3 * p2 * p1));
        float k2[16];
        LAS unsigned char* qb = lds + QB_OFF + (16 * tq) * 272 + d * 2;
#pragma unroll
        for (int ii = 0; ii < 16; ++ii) { const int i = DIR ? 15 - ii : ii;
            Pc *= f[i]; const float iP = __builtin_amdgcn_rcpf(Pc); const float kip = (1.f - f[i]) * iP;
            const unsigned wv = cvt_pk_bf16(qv[i] * Pc, kip);
            *(LAS unsigned short*)(qb + i * 272) = (unsigned short)(wv & 0xffffu);
            *(LAS unsigned short*)(qb + (KB_OFF - QB_OFF) + i * 272) = (unsigned short)(wv >> 16);
            k2[i] = kip * plast; }
        u32x4 k0, k1;
#pragma unroll
        for (int j = 0; j < 4; ++j) { k0[j] = cvt_pk_bf16(k2[2 * j], k2[2 * j + 1]); k1[j] = cvt_pk_bf16(k2[8 + 2 * j], k2[9 + 2 * j]); }
        LAS unsigned char* kt = lds + K2_OFF + d * 144 + tq * 32;
        *(LAS u32x4*)kt = k0; *(LAS u32x4*)(kt + 16) = k1;
        if (tq == 0) PL[d] = plast;
    }
    __syncthreads();
    const int tt = w & 3, vh = w >> 2;
    bf16x8 qbf[4];
#pragma unroll
    for (int ks = 0; ks < 4; ++ks) qbf[ks] = *(const LAS bf16x8*)(lds + QB_OFF + (16 * tt + q16) * 272 + (8 * g + 32 * ks) * 2);
    bf16x8 pa[2];
    {
        f32x4 at[4];
#pragma unroll
        for (int jt = 0; jt < 4; ++jt) {
            at[jt] = (f32x4){0.f, 0.f, 0.f, 0.f};
            const bool skip = DIR ? (jt < tt) : (jt > tt);
            if (!skip) {
                f32x4 acc = (f32x4){0.f, 0.f, 0.f, 0.f};
#pragma unroll
                for (int ks = 0; ks < 4; ++ks) { const bf16x8 a = *(const LAS bf16x8*)(lds + KB_OFF + (16 * jt + q16) * 272 + (8 * g + 32 * ks) * 2);
                    acc = __builtin_amdgcn_mfma_f32_16x16x32_bf16(a, qbf[ks], acc, 0, 0, 0); }
#pragma unroll
                for (int i = 0; i < 4; ++i) { const int j = 16 * jt + 4 * g + i, t = 16 * tt + q16; const bool keep = DIR ? (j >= t) : (j <= t); at[jt][i] = keep ? acc[i] : 0.f; }
            }
        }
#pragma unroll
        for (int kp = 0; kp < 2; ++kp) { u32x4 t; t.x = cvt_pk_bf16(at[2 * kp][0], at[2 * kp][1]); t.y = cvt_pk_bf16(at[2 * kp][2], at[2 * kp][3]);
            t.z = cvt_pk_bf16(at[2 * kp + 1][0], at[2 * kp + 1][1]); t.w = cvt_pk_bf16(at[2 * kp + 1][2], at[2 * kp + 1][3]); pa[kp] = __builtin_bit_cast(bf16x8, t); }
    }
    f32x4 ot[4];
#pragma unroll
    for (int vtl = 0; vtl < 4; ++vtl) {
        const int vrow = 16 * (4 * vh + vtl) + q16;
        f32x4 acc = (f32x4){0.f, 0.f, 0.f, 0.f};
#pragma unroll
        for (int ks = 0; ks < 4; ++ks) { const bf16x8 a = *(const LAS bf16x8*)(lds + ST_OFF + DIR * ST_DIR + vrow * 272 + (8 * g + 32 * ks) * 2);
            acc = __builtin_amdgcn_mfma_f32_16x16x32_bf16(a, qbf[ks], acc, 0, 0, 0); }
#pragma unroll
        for (int kp = 0; kp < 2; ++kp) { const LAS unsigned char* va = lds + VT_OFF + vrow * 144 + (32 * kp + 4 * g) * 2;
            const u32x2 lo = *(const LAS u32x2*)va, hi = *(const LAS u32x2*)(va + 32);
            u32x4 t; t.x = lo.x; t.y = lo.y; t.z = hi.x; t.w = hi.y;
            acc = __builtin_amdgcn_mfma_f32_16x16x32_bf16(__builtin_bit_cast(bf16x8, t), pa[kp], acc, 0, 0, 0); }
        ot[vtl] = acc;
    }
    {
        const size_t token = tok0 + 16 * tt + q16;
        float* op = OPART + token * 512 + h4 * 128 + 64 * vh + 4 * g;
        if (!fin) {
#pragma unroll
#ifndef NO_OPART_WRITE
            for (int vtl = 0; vtl < 4; ++vtl) *(f32x4*)(op + 16 * vtl) = ot[vtl];
#endif
            __syncthreads();
        } else {
            float ss = 0.f;
#pragma unroll
            for (int vtl = 0; vtl < 4; ++vtl) {
#ifndef NO_OPART_READ
                ot[vtl] += *(const f32x4*)(op + 16 * vtl);
#endif
                ss += (ot[vtl][0] * ot[vtl][0] + ot[vtl][1] * ot[vtl][1]) + (ot[vtl][2] * ot[vtl][2] + ot[vtl][3] * ot[vtl][3]); }
            ss += __shfl_xor(ss, 16); ss += __shfl_xor(ss, 32);
            if (g == 0) SSx[vh * 64 + 16 * tt + q16] = ss;
            __syncthreads();
            const float rstd = rsqrtf((SSx[16 * tt + q16] + SSx[64 + 16 * tt + q16]) * (1.f / 128.f) + RMS_EPS);
            const bf16_t* gp = PROJ + token * DIN + 3584 + h4 * 128 + 64 * vh + 4 * g;
#ifdef HG_WRITE_ELSEWHERE
            bf16_t* mp = (bf16_t*)OPART + token * DM + 512 + h4 * 128 + 64 * vh + 4 * g;
#else
            bf16_t* mp = MIX + token * DM + 512 + h4 * 128 + 64 * vh + 4 * g;
#endif
            const float* gw = p.hgw + 64 * vh + 4 * g;
#pragma unroll
            for (int vtl = 0; vtl < 4; ++vtl) {
                const u32x2 gr = *(const u32x2*)(gp + 16 * vtl); const f32x4 wv = *(const f32x4*)(gw + 16 * vtl);
                const float gv[4] = {bflo(gr.x), bfhi(gr.x), bflo(gr.y), bfhi(gr.y)}; float y[4];
#pragma unroll
                for (int i = 0; i < 4; ++i) { const float sg = gv[i] * __builtin_amdgcn_rcpf(1.f + __builtin_amdgcn_exp2f(-gv[i] * LOG2E)); y[i] = ot[vtl][i] * rstd * wv[i] * sg;
#ifdef HG_CONST_OUT
                    y[i] = 0.25f + 0.f * y[i];
#endif
                }
                u32x2 o2; o2.x = cvt_pk_bf16(y[0], y[1]); o2.y = cvt_pk_bf16(y[2], y[3]); *(u32x2*)(mp + 16 * vtl) = o2;
            }
        }
    }
    {
        bf16x8 vb[2];
#pragma unroll
        for (int ks = 0; ks < 2; ++ks) vb[ks] = *(const LAS bf16x8*)(lds + VT_OFF + (16 * w + q16) * 144 + (8 * g + 32 * ks) * 2);
#pragma unroll
        for (int dt = 0; dt < 8; ++dt) {
            const f32x4 pl = *(const LAS f32x4*)(lds + PL_OFF + (16 * dt + 4 * g) * 4);
            f32x4 acc = S[dt] * pl;
#pragma unroll
            for (int ks = 0; ks < 2; ++ks) { const bf16x8 a = *(const LAS bf16x8*)(lds + K2_OFF + (16 * dt + q16) * 144 + (8 * g + 32 * ks) * 2);
                acc = __builtin_amdgcn_mfma_f32_16x16x32_bf16(a, vb[ks], acc, 0, 0, 0); }
            S[dt] = acc;
            u32x2 sv; sv.x = cvt_pk_bf16(acc[0], acc[1]); sv.y = cvt_pk_bf16(acc[2], acc[3]);
            *(LAS u32x2*)(lds + ST_OFF + DIR * ST_DIR + (16 * w + q16) * 272 + (16 * dt + 4 * g) * 2) = sv;
        }
    }
    __syncthreads();
}

__device__ __forceinline__ void hg_item(LAS unsigned char* lds, const Params& p, const bf16_t* PROJ, bf16_t* MIX, float* OPART, int b, int h4) {
    const int tid = threadIdx.x, d = tid & 127;
    const float lbF = 1.f / (1.f + __expf(p.lbf[512 + h4 * 128 + d] - p.lbf[h4 * 128 + d]));
    const float lbB = 1.f / (1.f + __expf(p.lbb[512 + h4 * 128 + d] - p.lbb[h4 * 128 + d]));
    for (int i = tid; i < (2 * ST_DIR) / 4; i += NTHREADS) ((LAS unsigned*)(lds + ST_OFF))[i] = 0u;
    f32x4 Sf[8], Sb[8];
#pragma unroll
    for (int i = 0; i < 8; ++i) { Sf[i] = (f32x4){0.f, 0.f, 0.f, 0.f}; Sb[i] = (f32x4){0.f, 0.f, 0.f, 0.f}; }
    __syncthreads();
    for (int c = 0; c < 32; ++c) {
        hg_step<0>(lds, p, PROJ, MIX, OPART, b, h4, c, c >= 16, lbF, Sf);
        hg_step<1>(lds, p, PROJ, MIX, OPART, b, h4, 31 - c, c >= 16, lbB, Sb);
    }
}
}

#define GRID_SYNC(k) do { if (IN(k) && IN((k) + 1)) { asm volatile("s_waitcnt vmcnt(0) lgkmcnt(0)" ::: "memory"); __syncthreads(); grid.sync(); } } while (0)
#define IN(k) (ph_lo <= (k) && (k) < ph_hi)
#ifndef MK_N_LAUNCHES
#define MK_N_LAUNCHES 6
#endif
__global__ void __launch_bounds__(NTHREADS, 2) fwd_kernel(Params p, int ph_lo, int ph_hi) {
    extern __shared__ __attribute__((aligned(16))) unsigned char lds_raw[];
    LAS unsigned char* lds = (LAS unsigned char*)lds_raw;
    cg::grid_group grid = cg::this_grid();
    const int tid = threadIdx.x, lane = tid & 63, wave = __builtin_amdgcn_readfirstlane(tid >> 6);
    const int G = gridDim.x, blk = blockIdx.x;
    unsigned char* ws = p.ws;
    bf16_t* Wt_in = (bf16_t*)(ws + WS_WIN); bf16_t* Wt_out = (bf16_t*)(ws + WS_WOUT); bf16_t* Wt_up = (bf16_t*)(ws + WS_WUP); bf16_t* Wt_dn = (bf16_t*)(ws + WS_WDN);
    float* PART = (float*)(ws + WS_PART); bf16_t* U = (bf16_t*)(ws + WS_U); bf16_t* MIX = (bf16_t*)(ws + WS_MIX); bf16_t* PROJ = (bf16_t*)(ws + WS_PROJ); float* OPART = (float*)(ws + WS_OPART);

    if (IN(0)) {
        LAS float* scr = (LAS float*)(lds + wave * 16384);
        const int gw = blk * NWAVES + wave, NGW = G * NWAVES;
        constexpr int I_IN = (DM / 64) * (DIN / 32), I_OUT = (DM / 64) * (DM / 32), I_UP = (DM / 64) * (FF / 32), I_DN = (FF / 64) * (DM / 32);
        constexpr int NITEMS = I_IN + I_OUT + I_UP + I_DN;
        for (int it = gw; it < NITEMS; it += NGW) {
            int r = it;
            if (r < I_IN) { p0_transpose_item(p.w_in, DM, DIN, Wt_in, nullptr, scr, r, lane); continue; } r -= I_IN;
            if (r < I_OUT) { p0_transpose_item(p.w_out, DM, DM, Wt_out, nullptr, scr, r, lane); continue; } r -= I_OUT;
            if (r < I_UP) { p0_transpose_item(p.w_up, DM, FF, Wt_up, p.mnw, scr, r, lane); continue; } r -= I_UP;
            p0_transpose_item(p.w_dn, FF, DM, Wt_dn, nullptr, scr, r, lane);
        }
        f32x4 wv[4];
#pragma unroll
        for (int j = 0; j < 4; ++j) wv[j] = ((const f32x4*)p.anw)[lane + 64 * j];
        for (int m = gw; m < MROWS; m += NGW) rms_row_to_bf16(p.x + (size_t)m * DM, wv, U + (size_t)m * DM, lane);
#ifdef P0_FILL_MIX
        for (int m = gw; m < MROWS; m += NGW) { u32x4 c4; c4.x = c4.y = c4.z = c4.w = 0x3e803e80u; *((u32x4*)(MIX + (size_t)m * DM + 512) + lane) = c4; }
#endif
    }
    GRID_SYNC(0);
    if (IN(1)) {
        pg8::Gemm g{U, Wt_in, MROWS, DIN, DM}; pg8::StaticOrder S; S.init(MROWS, DIN, G, blk);
        pg8::EpiBf16 E{PROJ, DIN};
        pg8::gemm_phase<pg8::EpiBf16, pg8::StaticOrder, true, true>(lds, g, S, E);
    }
    GRID_SYNC(1);
    if (IN(2)) {
        const int GH = G / 2;
#ifndef SKIP_HG
        if (blk < GH) { for (int it = blk; it < BATCH * 4; it += GH) hg::hg_item(lds, p, PROJ, MIX, OPART, it >> 2, it & 3); }
#endif
#ifndef SKIP_NA
        if (blk >= GH) { for (int it = blk - GH; it < BATCH * 8; it += G - GH) na::na_item(lds, p, PROJ, MIX, it >> 3, it & 7); }
#endif
    }
    GRID_SYNC(2);
    if (IN(3)) {
        pg8::Gemm g{MIX, Wt_out, MROWS, DM, DM}; pg8::StaticOrder S; S.init(MROWS, DM, G, blk);
        pg8::EpiResid E{p.x, p.out, U, PART};
        pg8::gemm_phase<pg8::EpiResid, pg8::StaticOrder, true, true>(lds, g, S, E);
    }
    GRID_SYNC(3);
    if (IN(4)) {
        pg8::Gemm g{U, Wt_up, MROWS, FF, DM}; pg8::StaticOrder S; S.init(MROWS, FF, G, blk);
        pg8::EpiUp E{PROJ, FF, PART};
        pg8::gemm_phase<pg8::EpiUp, pg8::StaticOrder, true, true>(lds, g, S, E);
    }
    GRID_SYNC(4);
    if (IN(5)) {
        pg8::Gemm g{PROJ, Wt_dn, MROWS, DM, FF}; pg8::StaticOrder S; S.init(MROWS, DM, G, blk);
        pg8::EpiDown E{p.out};
        pg8::gemm_phase<pg8::EpiDown, pg8::StaticOrder, true, true>(lds, g, S, E);
    }
#ifdef DUMP_BUF
    if (IN(6)) {
        const bf16_t* src = DUMP_BUF == 1 ? MIX : (DUMP_BUF == 2 ? U : PROJ); const int ld = DUMP_BUF == 3 ? 4096 : 1024;
        for (size_t i = (size_t)blk * NTHREADS + tid; i < (size_t)MROWS * DM; i += (size_t)G * NTHREADS) { const size_t r = i >> 10, c = i & 1023; p.out[i] = bf2f(src[r * ld + c]); }
    }
#endif
}

extern "C" void kernel_launch(void* const* d_in, const int* in_sizes, int n_in, void* d_out, int out_size, void* d_ws, size_t ws_size, hipStream_t stream) {
    static int grid_blocks = 0;
    if (grid_blocks == 0) {
        if (n_in != 13 || in_sizes[0] != MROWS * DM || out_size != MROWS * DM || ws_size < WS_END) {
            fprintf(stderr, "kernel_launch: unexpected shapes: n_in %d in0 %d out %d ws %zu (need %zu)\n", n_in, n_in > 0 ? in_sizes[0] : -1, out_size, ws_size, (size_t)WS_END); grid_blocks = -1; return; }
        int dev = 0, cus = 0, per_cu = 0;
        (void)hipGetDevice(&dev);
        (void)hipDeviceGetAttribute(&cus, hipDeviceAttributeMultiprocessorCount, dev);
        if (hipFuncSetAttribute((const void*)fwd_kernel, hipFuncAttributeMaxDynamicSharedMemorySize, LDS_BYTES) != hipSuccess) { fprintf(stderr, "kernel_launch: hipFuncSetAttribute failed\n"); grid_blocks = -1; return; }
        (void)hipOccupancyMaxActiveBlocksPerMultiprocessor(&per_cu, (const void*)fwd_kernel, NTHREADS, LDS_BYTES);
        if (per_cu < 1) { fprintf(stderr, "kernel_launch: occupancy query says %d blocks per CU\n", per_cu); per_cu = 1; }
        if (per_cu > 1) per_cu = 1;
        grid_blocks = cus * per_cu;
        (void)hipGetLastError();
    }
    if (grid_blocks < 0) return;
    Params p{};
    p.x = (const float*)d_in[0]; p.w_in = (const float*)d_in[1]; p.w_out = (const float*)d_in[2]; p.anw = (const float*)d_in[3]; p.mnw = (const float*)d_in[4];
    p.qnw = (const float*)d_in[5]; p.knw = (const float*)d_in[6]; p.rpb = (const float*)d_in[7]; p.hgw = (const float*)d_in[8]; p.lbf = (const float*)d_in[9]; p.lbb = (const float*)d_in[10];
    p.w_up = (const float*)d_in[11]; p.w_dn = (const float*)d_in[12]; p.out = (float*)d_out; p.ws = (unsigned char*)d_ws;
    if (MK_N_LAUNCHES == 1) {
        int lo = 0, hi = 6;
        void* args[] = {&p, &lo, &hi};
        hipError_t e = hipLaunchCooperativeKernel((const void*)fwd_kernel, dim3(grid_blocks), dim3(NTHREADS), args, LDS_BYTES, stream);
        if (e != hipSuccess) fprintf(stderr, "kernel_launch: cooperative launch failed: %s (grid %d)\n", hipGetErrorString(e), grid_blocks);
    } else {
#ifdef DUMP_BUF
        const int NPH = 7;
#else
        const int NPH = 6;
#endif
        for (int k = 0; k < NPH; ++k) hipLaunchKernelGGL(fwd_kernel, dim3(grid_blocks), dim3(NTHREADS), LDS_BYTES, stream, p, k, k + 1);
    }
}
```

```cpp
#include <hip/hip_runtime.h>
#include <hip/hip_cooperative_groups.h>
#include <cstdio>
#include <cstdint>
namespace cg = cooperative_groups;

#define LAS __attribute__((address_space(3)))
typedef unsigned short bf16_t;
typedef short bf16x8 __attribute__((ext_vector_type(8)));
typedef float f32x4 __attribute__((ext_vector_type(4)));
typedef float f32x2 __attribute__((ext_vector_type(2)));
typedef unsigned u32x4 __attribute__((ext_vector_type(4)));
typedef unsigned u32x2 __attribute__((ext_vector_type(2)));

constexpr int BATCH = 32, SEQ = 2048, DM = 1024, MROWS = BATCH * SEQ, DIN = 4096, FF = 4096;
constexpr float RMS_EPS = 1e-6f;
constexpr float LOG2E = 1.4426950408889634f;
constexpr int NTHREADS = 512, NWAVES = 8;
constexpr int LDS_BYTES = 155648;

constexpr size_t MiB = 1u << 20;
constexpr size_t WS_WIN = 2 * MiB, WS_WOUT = 10 * MiB, WS_WUP = 12 * MiB, WS_WDN = 20 * MiB, WS_PART = 28 * MiB;
constexpr size_t WS_U = 32 * MiB;
constexpr size_t WS_MIX = 160 * MiB;
constexpr size_t WS_PROJ = 288 * MiB;
constexpr size_t WS_OPART = 800 * MiB;
constexpr size_t WS_END = 928 * MiB;

typedef __bf16 hwbf16x2 __attribute__((ext_vector_type(2)));
__device__ __forceinline__ unsigned cvt_pk_bf16(float lo, float hi) { const f32x2 v = {lo, hi}; const hwbf16x2 b = __builtin_convertvector(v, hwbf16x2); return __builtin_bit_cast(unsigned, b); }
__device__ __forceinline__ float bf2f(unsigned short v) { return __uint_as_float(((unsigned)v) << 16); }
__device__ __forceinline__ float bflo(unsigned w) { return __uint_as_float(w << 16); }
__device__ __forceinline__ float bfhi(unsigned w) { return __uint_as_float(w & 0xffff0000u); }
__device__ __forceinline__ float wave_sum(float v) {
#pragma unroll
    for (int o = 1; o < 64; o <<= 1) v += __shfl_xor(v, o);
    return v;
}
__device__ __forceinline__ float wave_max(float v) {
#pragma unroll
    for (int o = 1; o < 64; o <<= 1) v = fmaxf(v, __shfl_xor(v, o));
    return v;
}

namespace pg8 {
#define PG8_LAS __attribute__((address_space(3)))
constexpr int BM = 256, BK = 64, HALF = 128, HTB = HALF * BK * 2, STAGE_BYTES = 8 * HTB, NXCD = 8, WGM = 8;

__host__ __device__ __forceinline__ int lds_byte(int r, int c) { const int st = (r >> 4) * 2 + (c >> 5), rr = r & 15, cc = c & 31, ob = rr * 64 + cc * 2; return st * 1024 + (ob ^ (((ob >> 9) & 1) << 5)); }
__host__ __device__ __forceinline__ void stage_rc(int b, int& R, int& C) { const int st = b / 1024, sb = b % 1024, swz = sb ^ (((sb >> 9) & 1) << 5); R = (st >> 1) * 16 + swz / 64; C = (st & 1) * 32 + (swz % 64) / 2; }
__host__ __device__ __forceinline__ int perm32(int rho) { const int n = rho >> 4, i = rho & 15; return 8 * (i >> 2) + 4 * n + (i & 3); }

struct Unit { int pm, pn; };
struct Gemm { const bf16_t* A; const bf16_t* Bt; int M, N, K; };

struct StaticOrder {
    int nM, nN, nwg, G, c;
    __host__ __device__ void init(int M, int N, int G_, int c_) { nM = M / BM; nN = N / BM; nwg = nM * nN; G = G_; c = c_; }
    __host__ __device__ bool next(int i, Unit& u) const {
        const long L = (long)i * G + c; if (L >= nwg) return false;
        int wgid = (int)L; { const int q = nwg / NXCD, r = nwg % NXCD, xcd = wgid % NXCD, off = wgid / NXCD; wgid = (xcd < r ? xcd * (q + 1) : r * (q + 1) + (xcd - r) * q) + off; }
        const int nig = WGM * nN, gid = wgid / nig, fm = gid * WGM, gsz = (nM - fm) < WGM ? (nM - fm) : WGM;
        u.pm = fm + ((wgid % nig) % gsz); u.pn = (wgid % nig) / gsz; return true;
    }
    __device__ __forceinline__ void a_ready(const Unit&) const {}
    __device__ __forceinline__ void done(const Unit&) const {}
};

struct EpiBf16 {
    static constexpr bool PERM = true, AFTER_DRAIN = false;
    bf16_t* O; int ldc;
    __device__ __forceinline__ void operator()(const f32x4 (&acc)[2][2][4][2], const Unit& u, int wr, int wc, int fr, int fq) const {
        const int row0 = u.pm * BM + wr * 64 + fr; const int col0 = u.pn * BM + wc * 32 + 8 * fq;
#pragma unroll
        for (int ai = 0; ai < 2; ++ai)
#pragma unroll
            for (int m = 0; m < 4; ++m) { bf16_t* rowp = O + (size_t)(row0 + ai * HALF + m * 16) * ldc + col0;
#pragma unroll
                for (int bj = 0; bj < 2; ++bj) { const f32x4 v0 = acc[ai][bj][m][0], v1 = acc[ai][bj][m][1];
                    u32x4 w; w.x = cvt_pk_bf16(v0[0], v0[1]); w.y = cvt_pk_bf16(v0[2], v0[3]); w.z = cvt_pk_bf16(v1[0], v1[1]); w.w = cvt_pk_bf16(v1[2], v1[3]);
                    *(u32x4*)(rowp + bj * HALF) = w; } }
    }
};
struct EpiUp {
    static constexpr bool PERM = true, AFTER_DRAIN = false;
    bf16_t* O; int ldc; const float* part;
    __device__ __forceinline__ void operator()(const f32x4 (&acc)[2][2][4][2], const Unit& u, int wr, int wc, int fr, int fq) const {
        const int row0 = u.pm * BM + wr * 64 + fr; const int col0 = u.pn * BM + wc * 32 + 8 * fq;
#pragma unroll
        for (int ai = 0; ai < 2; ++ai)
#pragma unroll
            for (int m = 0; m < 4; ++m) { const int row = row0 + ai * HALF + m * 16; bf16_t* rowp = O + (size_t)row * ldc + col0;
                const f32x4* pp = (const f32x4*)(part + (size_t)row * 16); const f32x4 s4 = (pp[0] + pp[1]) + (pp[2] + pp[3]);
                const float rs = rsqrtf(((s4[0] + s4[1]) + (s4[2] + s4[3])) * (1.0f / DM) + RMS_EPS);
#pragma unroll
                for (int bj = 0; bj < 2; ++bj) { f32x4 v0 = acc[ai][bj][m][0] * rs, v1 = acc[ai][bj][m][1] * rs;
#pragma unroll
                    for (int e = 0; e < 4; ++e) { const float a = fmaxf(v0[e], 0.f), b = fmaxf(v1[e], 0.f); v0[e] = a * a; v1[e] = b * b; }
                    u32x4 w; w.x = cvt_pk_bf16(v0[0], v0[1]); w.y = cvt_pk_bf16(v0[2], v0[3]); w.z = cvt_pk_bf16(v1[0], v1[1]); w.w = cvt_pk_bf16(v1[2], v1[3]);
                    *(u32x4*)(rowp + bj * HALF) = w; } }
    }
};
struct EpiResid {
    static constexpr bool PERM = false, AFTER_DRAIN = false;
    const float* x; float* out; bf16_t* hb; float* part;
    __device__ __forceinline__ void operator()(const f32x4 (&acc)[2][2][4][2], const Unit& u, int wr, int wc, int fr, int fq) const {
        const int col0 = u.pn * BM + wc * 32 + 4 * fq;
#pragma unroll
        for (int ai = 0; ai < 2; ++ai)
#pragma unroll
            for (int m = 0; m < 4; ++m) { const int row = u.pm * BM + ai * HALF + wr * 64 + m * 16 + fr; const size_t off = (size_t)row * DM + col0; float ss = 0.f;
#pragma unroll
                for (int bj = 0; bj < 2; ++bj)
#pragma unroll
                    for (int n = 0; n < 2; ++n) { const size_t c = off + bj * HALF + n * 16; const f32x4 hv = *(const f32x4*)(x + c) + acc[ai][bj][m][n];
                        *(f32x4*)(out + c) = hv; ss += (hv[0] * hv[0] + hv[1] * hv[1]) + (hv[2] * hv[2] + hv[3] * hv[3]);
                        u32x2 w; w.x = cvt_pk_bf16(hv[0], hv[1]); w.y = cvt_pk_bf16(hv[2], hv[3]); *(u32x2*)(hb + c) = w; }
                ss += __shfl_xor(ss, 16); ss += __shfl_xor(ss, 32);
                if (fq == 0) part[(size_t)row * 16 + u.pn * 4 + wc] = ss; }
    }
};
struct EpiDown {
    static constexpr bool PERM = false, AFTER_DRAIN = false;
    float* out;
    __device__ __forceinline__ void operator()(const f32x4 (&acc)[2][2][4][2], const Unit& u, int wr, int wc, int fr, int fq) const {
        const int col0 = u.pn * BM + wc * 32 + 4 * fq;
#pragma unroll
        for (int ai = 0; ai < 2; ++ai)
#pragma unroll
            for (int m = 0; m < 4; ++m) { const int row = u.pm * BM + ai * HALF + wr * 64 + m * 16 + fr; const size_t off = (size_t)row * DM + col0;
#pragma unroll
                for (int bj = 0; bj < 2; ++bj)
#pragma unroll
                    for (int n = 0; n < 2; ++n) { const size_t c = off + bj * HALF + n * 16; *(f32x4*)(out + c) = *(const f32x4*)(out + c) + acc[ai][bj][m][n]; } }
    }
};

template <class Epi, class Sched, bool ALIGN_EPI = false, bool SP2 = false>
__device__ __forceinline__ void gemm_phase(PG8_LAS unsigned char* lds, const Gemm g, const Sched& S, const Epi& E) {
    const int tid = threadIdx.x, wid = __builtin_amdgcn_readfirstlane(tid >> 6), lane = tid & 63, wr = wid >> 2, wc = wid & 3, fr = lane & 15, fq = lane >> 4;
    const int K = g.K, nt = K / BK;
    unsigned voffA[2], voffB[2];
#pragma unroll
    for (int i = 0; i < 2; ++i) { int R, C; stage_rc(tid * 16 + i * 8192, R, C); const int Rb = Epi::PERM ? ((R & ~31) + perm32(R & 31)) : R;
        voffA[i] = (unsigned)(R * K + C) * 2u; voffB[i] = (unsigned)(Rb * K + C) * 2u; }
    const size_t kstep = (size_t)(BK * 2);
    const size_t hstep = (size_t)HALF * K * 2;
    const size_t tstep = 2 * hstep;
    const unsigned ldsw = (unsigned)wid * 1024u;
    const int aoff = lds_byte(wr * 64 + fr, fq * 8), boff = lds_byte(wc * 32 + fr, fq * 8);
#define PG8_SA(b, h) (((b) * 2 + (h)) * HTB)
#define PG8_SB(b, h) ((4 + (b) * 2 + (h)) * HTB)
#define PG8_STAGE(bufoff, gbase, voff) do { _Pragma("unroll") for (int _i = 0; _i < 2; ++_i) \
        __builtin_amdgcn_global_load_lds((const unsigned*)((const char*)(gbase) + (voff)[_i]), (PG8_LAS unsigned*)(lds + (bufoff) + ldsw + _i * 8192), 16, 0, 0); } while (0)
#define PG8_LDA(dst, b, h) do { _Pragma("unroll") for (int m = 0; m < 4; ++m) _Pragma("unroll") for (int k = 0; k < 2; ++k) dst[m][k] = *(const PG8_LAS bf16x8*)(lds + PG8_SA(b, h) + aoff + m * 2048 + k * 1024); } while (0)
#define PG8_LDB(dst, b, h) do { _Pragma("unroll") for (int n = 0; n < 2; ++n) _Pragma("unroll") for (int k = 0; k < 2; ++k) dst[n][k] = *(const PG8_LAS bf16x8*)(lds + PG8_SB(b, h) + boff + n * 2048 + k * 1024); } while (0)
#define PG8_MMA(ai, bj, At, Bt) do { __builtin_amdgcn_s_setprio(1); _Pragma("unroll") for (int m = 0; m < 4; ++m) _Pragma("unroll") for (int n = 0; n < 2; ++n) _Pragma("unroll") for (int k = 0; k < 2; ++k) \
        acc[ai][bj][m][n] = __builtin_amdgcn_mfma_f32_16x16x32_bf16(Bt[n][k], At[m][k], acc[ai][bj][m][n], 0, 0, 0); __builtin_amdgcn_s_setprio(0); } while (0)
#define PG8_WAIT_V(n) asm volatile("s_waitcnt vmcnt(" #n ")" ::: "memory")
#define PG8_WAIT_L(n) asm volatile("s_waitcnt lgkmcnt(" #n ")" ::: "memory")
#define PG8_BAR __builtin_amdgcn_s_barrier()
#define PG8_SCHED __builtin_amdgcn_sched_barrier(0)
    Unit cur, nxt; int ui = 0;
    if (!S.next(0, cur)) return;
    f32x4 acc[2][2][4][2];
#pragma unroll
    for (int a = 0; a < 2; ++a)
#pragma unroll
        for (int b = 0; b < 2; ++b)
#pragma unroll
            for (int m = 0; m < 4; ++m)
#pragma unroll
                for (int n = 0; n < 2; ++n) acc[a][b][m][n] = (f32x4){0.f, 0.f, 0.f, 0.f};
    bf16x8 At[4][2], B0[2][2], B1[2][2];
    const char* cA = (const char*)g.A + (size_t)cur.pm * tstep; const char* cB = (const char*)g.Bt + (size_t)cur.pn * tstep;
    S.a_ready(cur);
    if constexpr (SP2) {
        PG8_STAGE(PG8_SB(0, 0), cB, voffB); PG8_STAGE(PG8_SB(0, 1), cB + hstep, voffB); PG8_STAGE(PG8_SA(0, 0), cA, voffA); PG8_STAGE(PG8_SA(0, 1), cA + hstep, voffA);
        if (wr == 1) PG8_BAR;
        PG8_WAIT_V(2); PG8_BAR;
        PG8_STAGE(PG8_SB(1, 0), cB + kstep, voffB); PG8_STAGE(PG8_SA(1, 0), cA + kstep, voffA); PG8_STAGE(PG8_SB(1, 1), cB + hstep + kstep, voffB);
        PG8_WAIT_V(6); PG8_BAR;
    } else {
        PG8_STAGE(PG8_SB(0, 0), cB, voffB); PG8_STAGE(PG8_SA(0, 0), cA, voffA); PG8_STAGE(PG8_SB(0, 1), cB + hstep, voffB); PG8_STAGE(PG8_SA(0, 1), cA + hstep, voffA);
        if (wr == 1) PG8_BAR;
        PG8_WAIT_V(4); PG8_BAR;
        PG8_STAGE(PG8_SB(1, 0), cB + kstep, voffB); PG8_STAGE(PG8_SA(1, 0), cA + kstep, voffA); PG8_STAGE(PG8_SB(1, 1), cB + hstep + kstep, voffB);
        PG8_WAIT_V(6); PG8_BAR;
    }
    for (;;) {
        const bool has_next = S.next(ui + 1, nxt);
        const char* nA = has_next ? (const char*)g.A + (size_t)nxt.pm * tstep : cA; const char* nB = has_next ? (const char*)g.Bt + (size_t)nxt.pn * tstep : cB;
        for (int t = 0; t < nt; t += 2) {
            const bool last = (t == nt - 2);
            const char* a1 = cA + (size_t)(t + 1) * kstep;
            const char* a2 = last ? nA : cA + (size_t)(t + 2) * kstep; const char* b2 = last ? nB : cB + (size_t)(t + 2) * kstep;
            const char* a3 = a2 + kstep; const char* b3 = b2 + kstep;
            if (last && has_next) S.a_ready(nxt);
            if constexpr (SP2) {
            PG8_LDB(B0, 0, 0); PG8_LDB(B1, 0, 1); PG8_SCHED; PG8_LDA(At, 0, 0); PG8_STAGE(PG8_SA(1, 1), a1 + hstep, voffA);
            PG8_WAIT_V(8); PG8_WAIT_L(0); PG8_BAR; PG8_MMA(0, 0, At, B0); PG8_MMA(0, 1, At, B1); PG8_BAR; PG8_SCHED;
            PG8_LDA(At, 0, 1); PG8_STAGE(PG8_SB(0, 0), b2, voffB); PG8_STAGE(PG8_SB(0, 1), b2 + hstep, voffB); PG8_STAGE(PG8_SA(0, 0), a2, voffA);
            PG8_WAIT_V(8); PG8_WAIT_L(0); PG8_BAR; PG8_MMA(1, 0, At, B0); PG8_MMA(1, 1, At, B1); PG8_BAR; PG8_SCHED;
            PG8_LDB(B0, 1, 0); PG8_LDB(B1, 1, 1); PG8_SCHED; PG8_LDA(At, 1, 0); PG8_STAGE(PG8_SA(0, 1), a2 + hstep, voffA);
            PG8_WAIT_V(8); PG8_WAIT_L(0); PG8_BAR; PG8_MMA(0, 0, At, B0); PG8_MMA(0, 1, At, B1); PG8_BAR; PG8_SCHED;
            PG8_LDA(At, 1, 1); PG8_STAGE(PG8_SB(1, 0), b3, voffB); PG8_STAGE(PG8_SB(1, 1), b3 + hstep, voffB); PG8_STAGE(PG8_SA(1, 0), a3, voffA);
            PG8_WAIT_V(8); PG8_WAIT_L(0); PG8_BAR; PG8_MMA(1, 0, At, B0); PG8_MMA(1, 1, At, B1); PG8_BAR; PG8_SCHED;
            } else {
            PG8_LDB(B0, 0, 0); PG8_SCHED; PG8_LDA(At, 0, 0); PG8_STAGE(PG8_SA(1, 1), a1 + hstep, voffA);
            PG8_WAIT_L(8); PG8_BAR; PG8_WAIT_L(0); PG8_MMA(0, 0, At, B0); PG8_BAR; PG8_SCHED;
            PG8_LDB(B1, 0, 1); PG8_STAGE(PG8_SB(0, 0), b2, voffB);
            PG8_BAR; PG8_WAIT_L(0); PG8_MMA(0, 1, At, B1); PG8_BAR;
            PG8_LDA(At, 0, 1); PG8_STAGE(PG8_SA(0, 0), a2, voffA);
            PG8_BAR; PG8_WAIT_L(0); PG8_MMA(1, 0, At, B0); PG8_BAR; PG8_SCHED;
            PG8_STAGE(PG8_SB(0, 1), b2 + hstep, voffB);
            PG8_WAIT_V(6); PG8_BAR; PG8_MMA(1, 1, At, B1); PG8_BAR;
            PG8_LDB(B0, 1, 0); PG8_SCHED; PG8_LDA(At, 1, 0); PG8_STAGE(PG8_SA(0, 1), a2 + hstep, voffA);
            PG8_WAIT_L(8); PG8_BAR; PG8_WAIT_L(0); PG8_MMA(0, 0, At, B0); PG8_BAR; PG8_SCHED;
            PG8_LDB(B1, 1, 1); PG8_STAGE(PG8_SB(1, 0), b3, voffB);
            PG8_BAR; PG8_WAIT_L(0); PG8_MMA(0, 1, At, B1); PG8_BAR;
            PG8_LDA(At, 1, 1); PG8_STAGE(PG8_SA(1, 0), a3, voffA);
            PG8_BAR; PG8_WAIT_L(0); PG8_MMA(1, 0, At, B0); PG8_BAR; PG8_SCHED;
            PG8_STAGE(PG8_SB(1, 1), b3 + hstep, voffB);
            PG8_WAIT_V(6); PG8_BAR; PG8_MMA(1, 1, At, B1); PG8_BAR;
            }
        }
        if constexpr (ALIGN_EPI) { if (wr == 0) PG8_BAR; }
        if constexpr (!Epi::AFTER_DRAIN) { E(acc, cur, wr, wc, fr, fq); S.done(cur); }
        if (!has_next) break;
#pragma unroll
        for (int a = 0; a < 2; ++a)
#pragma unroll
            for (int b = 0; b < 2; ++b)
#pragma unroll
                for (int m = 0; m < 4; ++m)
#pragma unroll
                    for (int n = 0; n < 2; ++n) acc[a][b][m][n] = (f32x4){0.f, 0.f, 0.f, 0.f};
        cur = nxt; cA = nA; cB = nB; ++ui;
        if constexpr (ALIGN_EPI) { if (wr == 1) PG8_BAR; }
    }
    PG8_WAIT_V(0);
    if constexpr (!ALIGN_EPI) { if (wr == 0) PG8_BAR; }
    PG8_BAR;
#undef PG8_SA
#undef PG8_SB
#undef PG8_STAGE
#undef PG8_LDA
#undef PG8_LDB
#undef PG8_MMA
#undef PG8_WAIT_V
#undef PG8_WAIT_L
#undef PG8_BAR
#undef PG8_SCHED
}
}

struct Params {
    const float *x, *w_in, *w_out, *anw, *mnw, *qnw, *knw, *rpb, *hgw, *lbf, *lbb, *w_up, *w_dn;
    float* out; unsigned char* ws;
};

__device__ __forceinline__ void p0_transpose_item(const float* W, int K, int N, bf16_t* WT, const float* scale, LAS float* scr, int item, int lane) {
    const int nblk = N / 32, kb = item / nblk, nb = item % nblk, k0 = 64 * kb, n0 = 32 * nb;
#pragma unroll 8
    for (int i = 0; i < 32; ++i) { const int kk = 2 * i + (lane >> 5); float v = W[(size_t)(k0 + kk) * N + n0 + (lane & 31)]; if (scale) v *= scale[k0 + kk]; scr[kk * 33 + (lane & 31)] = v; }
    asm volatile("s_waitcnt lgkmcnt(0)" ::: "memory");
    const int c = lane & 7;
#pragma unroll
    for (int j = 0; j < 4; ++j) { const int n = (lane >> 3) + 8 * j; const LAS float* s = scr + (8 * c) * 33 + n;
        u32x4 o; o.x = cvt_pk_bf16(s[0 * 33], s[1 * 33]); o.y = cvt_pk_bf16(s[2 * 33], s[3 * 33]); o.z = cvt_pk_bf16(s[4 * 33], s[5 * 33]); o.w = cvt_pk_bf16(s[6 * 33], s[7 * 33]);
        *(u32x4*)(WT + (size_t)(n0 + n) * K + k0 + 8 * c) = o; }
    asm volatile("s_waitcnt lgkmcnt(0)" ::: "memory");
}
__device__ __forceinline__ void rms_row_to_bf16(const float* xrow, const f32x4 (&wv)[4], bf16_t* orow, int lane) {
    const f32x4* xr = (const f32x4*)xrow + lane;
    f32x4 v[4]; float s = 0.f;
#pragma unroll
    for (int j = 0; j < 4; ++j) { v[j] = xr[64 * j]; s += (v[j].x * v[j].x + v[j].y * v[j].y) + (v[j].z * v[j].z + v[j].w * v[j].w); }
    const float rstd = rsqrtf(wave_sum(s) * (1.f / DM) + RMS_EPS);
    u32x2* o8 = (u32x2*)orow + lane;
#pragma unroll
    for (int j = 0; j < 4; ++j) { const f32x4 y = v[j] * rstd * wv[j]; u32x2 w; w.x = cvt_pk_bf16(y.x, y.y); w.y = cvt_pk_bf16(y.z, y.w); o8[64 * j] = w; }
}

namespace na {
constexpr int KR_OFF = 0;
constexpr int VT_OFF = 65536;
constexpr int VT_SLOT = 64 * 136;
constexpr int RPB_OFF = VT_OFF + 8 * VT_SLOT;
constexpr int MRG_OFF = RPB_OFF + 2048;
constexpr int END = MRG_OFF + 17408;
static_assert(END <= LDS_BYTES, "na lds");

__device__ __forceinline__ void na_item(LAS unsigned char* lds, const Params& p, const bf16_t* PROJ, bf16_t* MIX, int b, int h) {
    const int tid = threadIdx.x, w = __builtin_amdgcn_readfirstlane(tid >> 6), l = tid & 63;
    const int n = w & 3, half = w >> 2, q16 = l & 15, g = l >> 4;
    LAS float* RPB = (LAS float*)(lds + RPB_OFF);
    const float mq = wave_max(fabsf(p.qnw[l])), mk = wave_max(fabsf(p.knw[l]));
    float mr = 0.f;
    for (int i = l; i < 465; i += 64) mr = fmaxf(mr, fabsf(p.rpb[h * 465 + i]));
    mr = wave_max(mr);
    for (int i = tid; i < 465; i += NTHREADS) RPB[i] = p.rpb[h * 465 + i] * LOG2E;
    const float Mshift = (64.f * mq * mk * 0.125f + mr) * LOG2E;
    float qsw[2][8];
#pragma unroll
    for (int ks = 0; ks < 2; ++ks)
#pragma unroll
        for (int j = 0; j < 8; ++j) qsw[ks][j] = p.qnw[8 * g + 32 * ks + j] * (0.125f * LOG2E);
    const int lc = tid >> 3, ldg = tid & 7;
    float knw[8];
#pragma unroll
    for (int j = 0; j < 8; ++j) knw[j] = p.knw[ldg * 8 + j];
    const int lsw = (lc ^ (lc >> 3)) & 7;
    __syncthreads();
    const int c = 16 * n + q16;
    const int cs = min(max(c - 8, 0), 48), bs = min(max(16 * n - 8, 0), 32);
    int nl = 0;
    for (int r = 0; r < 32; ++r) {
        const int start = min(max(r - 4, 0), 24);
        while (nl < start + 8) {
            const int slot = nl & 7;
            const bf16_t* gp = PROJ + (size_t)(b * SEQ + nl * 64 + lc) * DIN + 512 + h * 64 + ldg * 8;
            const u32x4 kv = *(const u32x4*)gp, vv = *(const u32x4*)(gp + 512);
            float kf[8];
#pragma unroll
            for (int j = 0; j < 4; ++j) { kf[2 * j] = bflo(kv[j]); kf[2 * j + 1] = bfhi(kv[j]); }
            float ss = 0.f;
#pragma unroll
            for (int j = 0; j < 8; ++j) ss += kf[j] * kf[j];
            ss += __shfl_xor(ss, 1); ss += __shfl_xor(ss, 2); ss += __shfl_xor(ss, 4);
            const float rstd = rsqrtf(ss * (1.f / 64.f) + RMS_EPS);
            u32x4 ko;
#pragma unroll
            for (int j = 0; j < 4; ++j) ko[j] = cvt_pk_bf16(kf[2 * j] * rstd * knw[2 * j], kf[2 * j + 1] * rstd * knw[2 * j + 1]);
            *(LAS u32x4*)(lds + KR_OFF + slot * 8192 + lc * 128 + ((ldg ^ lsw) << 4)) = ko;
            LAS unsigned char* vb = lds + VT_OFF + slot * VT_SLOT + (ldg * 8) * 136 + lc * 2;
#pragma unroll
            for (int j = 0; j < 4; ++j) { *(LAS unsigned short*)(vb + (2 * j) * 136) = (unsigned short)(vv[j] & 0xffffu); *(LAS unsigned short*)(vb + (2 * j + 1) * 136) = (unsigned short)(vv[j] >> 16); }
            ++nl;
        }
        bf16x8 bq[2];
        {
            const bf16_t* qp = PROJ + (size_t)(b * SEQ + r * 64 + c) * DIN + h * 64 + 8 * g;
            const u32x4 q0 = *(const u32x4*)qp, q1 = *(const u32x4*)(qp + 32);
            float qf[2][8];
#pragma unroll
            for (int j = 0; j < 4; ++j) { qf[0][2 * j] = bflo(q0[j]); qf[0][2 * j + 1] = bfhi(q0[j]); qf[1][2 * j] = bflo(q1[j]); qf[1][2 * j + 1] = bfhi(q1[j]); }
            float ss = 0.f;
#pragma unroll
            for (int j = 0; j < 8; ++j) ss += qf[0][j] * qf[0][j] + qf[1][j] * qf[1][j];
            ss += __shfl_xor(ss, 16); ss += __shfl_xor(ss, 32);
            const float rstd = rsqrtf(ss * (1.f / 64.f) + RMS_EPS);
#pragma unroll
            for (int ks = 0; ks < 2; ++ks) { u32x4 t;
#pragma unroll
                for (int j = 0; j < 4; ++j) t[j] = cvt_pk_bf16(qf[ks][2 * j] * rstd * qsw[ks][2 * j], qf[ks][2 * j + 1] * rstd * qsw[ks][2 * j + 1]);
                bq[ks] = __builtin_bit_cast(bf16x8, t); }
        }
        __syncthreads();
        f32x4 o[4];
#pragma unroll
        for (int dt = 0; dt < 4; ++dt) o[dt] = (f32x4){0.f, 0.f, 0.f, 0.f};
        float lsum = 0.f;
#pragma unroll
        for (int krl = 0; krl < 4; ++krl) {
            const int R = start + 4 * half + krl, slot = R & 7, ridx = R - r + 7;
            const LAS unsigned char* kbase = lds + KR_OFF + slot * 8192;
            f32x4 s[2];
#pragma unroll
            for (int ct = 0; ct < 2; ++ct) {
                const int kcol = bs + 16 * ct + q16, sw = (kcol ^ (kcol >> 3)) & 7;
                const bf16x8 a0 = *(const LAS bf16x8*)(kbase + kcol * 128 + ((g ^ sw) << 4));
                const bf16x8 a1 = *(const LAS bf16x8*)(kbase + kcol * 128 + (((g + 4) ^ sw) << 4));
                f32x4 acc = (f32x4){0.f, 0.f, 0.f, 0.f};
                acc = __builtin_amdgcn_mfma_f32_16x16x32_bf16(a0, bq[0], acc, 0, 0, 0);
                acc = __builtin_amdgcn_mfma_f32_16x16x32_bf16(a1, bq[1], acc, 0, 0, 0);
                s[ct] = acc;
            }
            float pv[2][4];
#pragma unroll
            for (int ct = 0; ct < 2; ++ct)
#pragma unroll
                for (int i = 0; i < 4; ++i) {
                    const int kc = bs + 16 * ct + 4 * g + i; const bool valid = (unsigned)(kc - cs) < 16u;
                    const int idx = valid ? (ridx * 31 + (kc - c + 15)) : 0;
                    const float bias = RPB[idx];
                    const float e = __builtin_amdgcn_exp2f(s[ct][i] + bias - Mshift);
                    pv[ct][i] = valid ? e : 0.f; lsum += pv[ct][i];
                }
            u32x4 pw; pw.x = cvt_pk_bf16(pv[0][0], pv[0][1]); pw.y = cvt_pk_bf16(pv[0][2], pv[0][3]); pw.z = cvt_pk_bf16(pv[1][0], pv[1][1]); pw.w = cvt_pk_bf16(pv[1][2], pv[1][3]);
            const bf16x8 pb = __builtin_bit_cast(bf16x8, pw);
            const LAS unsigned char* vbase = lds + VT_OFF + slot * VT_SLOT + (bs + 4 * g) * 2;
#pragma unroll
            for (int dt = 0; dt < 4; ++dt) {
                const LAS unsigned char* va = vbase + (16 * dt + q16) * 136;
                const u32x2 lo = *(const LAS u32x2*)va, hi = *(const LAS u32x2*)(va + 32);
                u32x4 t; t.x = lo.x; t.y = lo.y; t.z = hi.x; t.w = hi.y;
                o[dt] = __builtin_amdgcn_mfma_f32_16x16x32_bf16(__builtin_bit_cast(bf16x8, t), pb, o[dt], 0, 0, 0);
            }
        }
        lsum += __shfl_xor(lsum, 16); lsum += __shfl_xor(lsum, 32);
        LAS float* mg = (LAS float*)(lds + MRG_OFF) + ((w & 3) * 64 + l) * 17;
        if (half == 1) {
#pragma unroll
            for (int dt = 0; dt < 4; ++dt)
#pragma unroll
                for (int i = 0; i < 4; ++i) mg[dt * 4 + i] = o[dt][i];
            mg[16] = lsum;
        }
        __syncthreads();
        if (half == 0) {
            const float inv = 1.0f / (lsum + mg[16]);
            bf16_t* op = MIX + (size_t)(b * SEQ + r * 64 + c) * DM + h * 64 + 4 * g;
#pragma unroll
            for (int dt = 0; dt < 4; ++dt) { u32x2 wv; wv.x = cvt_pk_bf16((o[dt][0] + mg[dt * 4 + 0]) * inv, (o[dt][1] + mg[dt * 4 + 1]) * inv);
                wv.y = cvt_pk_bf16((o[dt][2] + mg[dt * 4 + 2]) * inv, (o[dt][3] + mg[dt * 4 + 3]) * inv); *(u32x2*)(op + 16 * dt) = wv; }
        }
    }
    __syncthreads();
}
}

namespace hg {
constexpr int ST_OFF = 0;
constexpr int ST_DIR = 128 * 272;
constexpr int QB_OFF = 2 * ST_DIR;
constexpr int KB_OFF = QB_OFF + 17408;
constexpr int K2_OFF = KB_OFF + 17408;
constexpr int VT_OFF = K2_OFF + 18432;
constexpr int PT_OFF = VT_OFF + 18432;
constexpr int PL_OFF = PT_OFF + 2048;
constexpr int SS_OFF = PL_OFF + 512;
constexpr int END = SS_OFF + 512;
static_assert(END <= LDS_BYTES, "hg lds");

template <int DIR>
__device__ __forceinline__ void hg_step(LAS unsigned char* lds, const Params& p, const bf16_t* PROJ, bf16_t* MIX, float* OPART, int b, int h4, int ch, bool fin, float lb, f32x4 (&S)[8]) {
    const int tid = threadIdx.x, w = __builtin_amdgcn_readfirstlane(tid >> 6), l = tid & 63, q16 = l & 15, g = l >> 4;
    const size_t tok0 = (size_t)b * SEQ + (size_t)ch * 64;
    const int d = tid & 127, tq = tid >> 7;
    LAS float* PT = (LAS float*)(lds + PT_OFF); LAS float* PL = (LAS float*)(lds + PL_OFF); LAS float* SSx = (LAS float*)(lds + SS_OFF);
    float f[16], qv[16];
    {
        const bf16_t* base = PROJ + (tok0 + 16 * tq) * DIN + h4 * 128 + d;
        const bf16_t* hfp = base + (DIR ? 2560 : 2048); const bf16_t* qp = base + 1536; const bf16_t* vp = base + 3072;
        unsigned short hraw[16], vraw[16];
#pragma unroll
        for (int i = 0; i < 16; ++i) { hraw[i] = hfp[(size_t)i * DIN]; qv[i] = bf2f(qp[(size_t)i * DIN]); vraw[i] = vp[(size_t)i * DIN]; }
        float tot = 1.f;
#pragma unroll
        for (int i = 0; i < 16; ++i) { const float e = __builtin_amdgcn_exp2f(-bf2f(hraw[i]) * LOG2E); const float r = __builtin_amdgcn_rcpf(1.f + e); f[i] = lb + (1.f - lb) * r; tot *= f[i]; }
        PT[tq * 128 + d] = tot;
        u32x4 v0, v1;
#pragma unroll
        for (int j = 0; j < 4; ++j) { v0[j] = (unsigned)vraw[2 * j] | ((unsigned)vraw[2 * j + 1] << 16); v1[j] = (unsigned)vraw[8 + 2 * j] | ((unsigned)vraw[9 + 2 * j] << 16); }
        LAS unsigned char* vt = lds + VT_OFF + d * 144 + tq * 32;
        *(LAS u32x4*)vt = v0; *(LAS u32x4*)(vt + 16) = v1;
    }
    __syncthreads();
    {
        const float p0 = PT[d], p1 = PT[128 + d], p2 = PT[256 + d], p3 = PT[384 + d];
        const float plast = (p0 * p1) * (p2 * p3);
        float Pc;
        if (!DIR) Pc = tq == 0 ? 1.f : (tq == 1 ? p0 : (tq == 2 ? p0 * p1 : p0 * p1 * p2));
        else      Pc = tq == 3 ? 1.f : (tq == 2 ? p3 : (tq == 1 ? p3 * p2 : p3 * p2 * p1));
        float k2[16];
        LAS unsigned char* qb = lds + QB_OFF + (16 * tq) * 272 + d * 2;
#pragma unroll
        for (int ii = 0; ii < 16; ++ii) { const int i = DIR ? 15 - ii : ii;
            Pc *= f[i]; const float iP = __builtin_amdgcn_rcpf(Pc); const float kip = (1.f - f[i]) * iP;
            const unsigned wv = cvt_pk_bf16(qv[i] * Pc, kip);
            *(LAS unsigned short*)(qb + i * 272) = (unsigned short)(wv & 0xffffu);
            *(LAS unsigned short*)(qb + (KB_OFF - QB_OFF) + i * 272) = (unsigned short)(wv >> 16);
            k2[i] = kip * plast; }
        u32x4 k0, k1;
#pragma unroll
        for (int j = 0; j < 4; ++j) { k0[j] = cvt_pk_bf16(k2[2 * j], k2[2 * j + 1]); k1[j] = cvt_pk_bf16(k2[8 + 2 * j], k2[9 + 2 * j]); }
        LAS unsigned char* kt = lds + K2_OFF + d * 144 + tq * 32;
        *(LAS u32x4*)kt = k0; *(LAS u32x4*)(kt + 16) = k1;
        if (tq == 0) PL[d] = plast;
    }
    __syncthreads();
    const int tt = w & 3, vh = w >> 2;
    bf16x8 qbf[4];
#pragma unroll
    for (int ks = 0; ks < 4; ++ks) qbf[ks] = *(const LAS bf16x8*)(lds + QB_OFF + (16 * tt + q16) * 272 + (8 * g + 32 * ks) * 2);
    bf16x8 pa[2];
    {
        f32x4 at[4];
#pragma unroll
        for (int jt = 0; jt < 4; ++jt) {
            at[jt] = (f32x4){0.f, 0.f, 0.f, 0.f};
            const bool skip = DIR ? (jt < tt) : (jt > tt);
            if (!skip) {
                f32x4 acc = (f32x4){0.f, 0.f, 0.f, 0.f};
#pragma unroll
                for (int ks = 0; ks < 4; ++ks) { const bf16x8 a = *(const LAS bf16x8*)(lds + KB_OFF + (16 * jt + q16) * 272 + (8 * g + 32 * ks) * 2);
                    acc = __builtin_amdgcn_mfma_f32_16x16x32_bf16(a, qbf[ks], acc, 0, 0, 0); }
#pragma unroll
                for (int i = 0; i < 4; ++i) { const int j = 16 * jt + 4 * g + i, t = 16 * tt + q16; const bool keep = DIR ? (j >= t) : (j <= t); at[jt][i] = keep ? acc[i] : 0.f; }
            }
        }
#pragma unroll
        for (int kp = 0; kp < 2; ++kp) { u32x4 t; t.x = cvt_pk_bf16(at[2 * kp][0], at[2 * kp][1]); t.y = cvt_pk_bf16(at[2 * kp][2], at[2 * kp][3]);
            t.z = cvt_pk_bf16(at[2 * kp + 1][0], at[2 * kp + 1][1]); t.w = cvt_pk_bf16(at[2 * kp + 1][2], at[2 * kp + 1][3]); pa[kp] = __builtin_bit_cast(bf16x8, t); }
    }
    f32x4 ot[4];
#pragma unroll
    for (int vtl = 0; vtl < 4; ++vtl) {
        const int vrow = 16 * (4 * vh + vtl) + q16;
        f32x4 acc = (f32x4){0.f, 0.f, 0.f, 0.f};
#pragma unroll
        for (int ks = 0; ks < 4; ++ks) { const bf16x8 a = *(const LAS bf16x8*)(lds + ST_OFF + DIR * ST_DIR + vrow * 272 + (8 * g + 32 * ks) * 2);
            acc = __builtin_amdgcn_mfma_f32_16x16x32_bf16(a, qbf[ks], acc, 0, 0, 0); }
#pragma unroll
        for (int kp = 0; kp < 2; ++kp) { const LAS unsigned char* va = lds + VT_OFF + vrow * 144 + (32 * kp + 4 * g) * 2;
            const u32x2 lo = *(const LAS u32x2*)va, hi = *(const LAS u32x2*)(va + 32);
            u32x4 t; t.x = lo.x; t.y = lo.y; t.z = hi.x; t.w = hi.y;
            acc = __builtin_amdgcn_mfma_f32_16x16x32_bf16(__builtin_bit_cast(bf16x8, t), pa[kp], acc, 0, 0, 0); }
        ot[vtl] = acc;
    }
    {
        const size_t token = tok0 + 16 * tt + q16;
        float* op = OPART + token * 512 + h4 * 128 + 64 * vh + 4 * g;
        if (!fin) {
#pragma unroll
#ifndef NO_OPART_WRITE
            for (int vtl = 0; vtl < 4; ++vtl) *(f32x4*)(op + 16 * vtl) = ot[vtl];
#endif
            __syncthreads();
        } else {
            float ss = 0.f;
#pragma unroll
            for (int vtl = 0; vtl < 4; ++vtl) {
#ifndef NO_OPART_READ
                ot[vtl] += *(const f32x4*)(op + 16 * vtl);
#endif
                ss += (ot[vtl][0] * ot[vtl][0] + ot[vtl][1] * ot[vtl][1]) + (ot[vtl][2] * ot[vtl][2] + ot[vtl][3] * ot[vtl][3]); }
            ss += __shfl_xor(ss, 16); ss += __shfl_xor(ss, 32);
            if (g == 0) SSx[vh * 64 + 16 * tt + q16] = ss;
            __syncthreads();
            const float rstd = rsqrtf((SSx[16 * tt + q16] + SSx[64 + 16 * tt + q16]) * (1.f / 128.f) + RMS_EPS);
            const bf16_t* gp = PROJ + token * DIN + 3584 + h4 * 128 + 64 * vh + 4 * g;
#ifdef HG_WRITE_ELSEWHERE
            bf16_t* mp = (bf16_t*)OPART + token * DM + 512 + h4 * 128 + 64 * vh + 4 * g;
#else
            bf16_t* mp = MIX + token * DM + 512 + h4 * 128 + 64 * vh + 4 * g;
#endif
            const float* gw = p.hgw + 64 * vh + 4 * g;
#pragma unroll
            for (int vtl = 0; vtl < 4; ++vtl) {
                const u32x2 gr = *(const u32x2*)(gp + 16 * vtl); const f32x4 wv = *(const f32x4*)(gw + 16 * vtl);
                const float gv[4] = {bflo(gr.x), bfhi(gr.x), bflo(gr.y), bfhi(gr.y)}; float y[4];
#pragma unroll
                for (int i = 0; i < 4; ++i) { const float sg = gv[i] * __builtin_amdgcn_rcpf(1.f + __builtin_amdgcn_exp2f(-gv[i] * LOG2E)); y[i] = ot[vtl][i] * rstd * wv[i] * sg;
#ifdef HG_CONST_OUT
                    y[i] = 0.25f + 0.f * y[i];
#endif
                }
                u32x2 o2; o2.x = cvt_pk_bf16(y[0], y[1]); o2.y = cvt_pk_bf16(y[2], y[3]); *(u32x2*)(mp + 16 * vtl) = o2;
            }
        }
    }
    {
        bf16x8 vb[2];
#pragma unroll
        for (int ks = 0; ks < 2; ++ks) vb[ks] = *(const LAS bf16x8*)(lds + VT_OFF + (16 * w + q16) * 144 + (8 * g + 32 * ks) * 2);
#pragma unroll
        for (int dt = 0; dt < 8; ++dt) {
            const f32x4 pl = *(const LAS f32x4*)(lds + PL_OFF + (16 * dt + 4 * g) * 4);
            f32x4 acc = S[dt] * pl;
#pragma unroll
            for (int ks = 0; ks < 2; ++ks) { const bf16x8 a = *(const LAS bf16x8*)(lds + K2_OFF + (16 * dt + q16) * 144 + (8 * g + 32 * ks) * 2);
                acc = __builtin_amdgcn_mfma_f32_16x16x32_bf16(a, vb[ks], acc, 0, 0, 0); }
            S[dt] = acc;
            u32x2 sv; sv.x = cvt_pk_bf16(acc[0], acc[1]); sv.y = cvt_pk_bf16(acc[2], acc[3]);
            *(LAS u32x2*)(lds + ST_OFF + DIR * ST_DIR + (16 * w + q16) * 272 + (16 * dt + 4 * g) * 2) = sv;
        }
    }
    __syncthreads();
}

__device__ __forceinline__ void hg_item(LAS unsigned char* lds, const Params& p, const bf16_t* PROJ, bf16_t* MIX, float* OPART, int b, int h4) {
    const int tid = threadIdx.x, d = tid & 127;
    const float lbF = 1.f / (1.f + __expf(p.lbf[512 + h4 * 128 + d] - p.lbf[h4 * 128 + d]));
    const float lbB = 1.f / (1.f + __expf(p.lbb[512 + h4 * 128 + d] - p.lbb[h4 * 128 + d]));
    for (int i = tid; i < (2 * ST_DIR) / 4; i += NTHREADS) ((LAS unsigned*)(lds + ST_OFF))[i] = 0u;
    f32x4 Sf[8], Sb[8];
#pragma unroll
    for (int i = 0; i < 8; ++i) { Sf[i] = (f32x4){0.f, 0.f, 0.f, 0.f}; Sb[i] = (f32x4){0.f, 0.f, 0.f, 0.f}; }
    __syncthreads();
    for (int c = 0; c < 32; ++c) {
        hg_step<0>(lds, p, PROJ, MIX, OPART, b, h4, c, c >= 16, lbF, Sf);
        hg_step<1>(lds, p, PROJ, MIX, OPART, b, h4, 31 - c, c >= 16, lbB, Sb);
    }
}
}

#define GRID_SYNC(k) do { if (IN(k) && IN((k) + 1)) { asm volatile("s_waitcnt vmcnt(0) lgkmcnt(0)" ::: "memory"); __syncthreads(); grid.sync(); } } while (0)
#define IN(k) (ph_lo <= (k) && (k) < ph_hi)
#ifndef MK_N_LAUNCHES
#define MK_N_LAUNCHES 1
#endif
__global__ void __launch_bounds__(NTHREADS, 2) fwd_kernel(Params p, int ph_lo, int ph_hi) {
    extern __shared__ __attribute__((aligned(16))) unsigned char lds_raw[];
    LAS unsigned char* lds = (LAS unsigned char*)lds_raw;
    cg::grid_group grid = cg::this_grid();
    const int tid = threadIdx.x, lane = tid & 63, wave = __builtin_amdgcn_readfirstlane(tid >> 6);
    const int G = gridDim.x, blk = blockIdx.x;
    unsigned char* ws = p.ws;
    bf16_t* Wt_in = (bf16_t*)(ws + WS_WIN); bf16_t* Wt_out = (bf16_t*)(ws + WS_WOUT); bf16_t* Wt_up = (bf16_t*)(ws + WS_WUP); bf16_t* Wt_dn = (bf16_t*)(ws + WS_WDN);
    float* PART = (float*)(ws + WS_PART); bf16_t* U = (bf16_t*)(ws + WS_U); bf16_t* MIX = (bf16_t*)(ws + WS_MIX); bf16_t* PROJ = (bf16_t*)(ws + WS_PROJ); float* OPART = (float*)(ws + WS_OPART);

    if (IN(0)) {
        LAS float* scr = (LAS float*)(lds + wave * 16384);
        const int gw = blk * NWAVES + wave, NGW = G * NWAVES;
        constexpr int I_IN = (DM / 64) * (DIN / 32), I_OUT = (DM / 64) * (DM / 32), I_UP = (DM / 64) * (FF / 32), I_DN = (FF / 64) * (DM / 32);
        constexpr int NITEMS = I_IN + I_OUT + I_UP + I_DN;
        for (int it = gw; it < NITEMS; it += NGW) {
            int r = it;
            if (r < I_IN) { p0_transpose_item(p.w_in, DM, DIN, Wt_in, nullptr, scr, r, lane); continue; } r -= I_IN;
            if (r < I_OUT) { p0_transpose_item(p.w_out, DM, DM, Wt_out, nullptr, scr, r, lane); continue; } r -= I_OUT;
            if (r < I_UP) { p0_transpose_item(p.w_up, DM, FF, Wt_up, p.mnw, scr, r, lane); continue; } r -= I_UP;
            p0_transpose_item(p.w_dn, FF, DM, Wt_dn, nullptr, scr, r, lane);
        }
        f32x4 wv[4];
#pragma unroll
        for (int j = 0; j < 4; ++j) wv[j] = ((const f32x4*)p.anw)[lane + 64 * j];
        for (int m = gw; m < MROWS; m += NGW) rms_row_to_bf16(p.x + (size_t)m * DM, wv, U + (size_t)m * DM, lane);
#ifdef P0_FILL_MIX
        for (int m = gw; m < MROWS; m += NGW) { u32x4 c4; c4.x = c4.y = c4.z = c4.w = 0x3e803e80u; *((u32x4*)(MIX + (size_t)m * DM + 512) + lane) = c4; }
#endif
    }
    GRID_SYNC(0);
    if (IN(1)) {
        pg8::Gemm g{U, Wt_in, MROWS, DIN, DM}; pg8::StaticOrder S; S.init(MROWS, DIN, G, blk);
        pg8::EpiBf16 E{PROJ, DIN};
        pg8::gemm_phase<pg8::EpiBf16, pg8::StaticOrder, true, true>(lds, g, S, E);
    }
    GRID_SYNC(1);
    if (IN(2)) {
        const int GH = G / 2;
#ifndef SKIP_HG
        if (blk < GH) { for (int it = blk; it < BATCH * 4; it += GH) hg::hg_item(lds, p, PROJ, MIX, OPART, it >> 2, it & 3); }
#endif
#ifndef SKIP_NA
        if (blk >= GH) { for (int it = blk - GH; it < BATCH * 8; it += G - GH) na::na_item(lds, p, PROJ, MIX, it >> 3, it & 7); }
#endif
    }
    GRID_SYNC(2);
    if (IN(3)) {
        pg8::Gemm g{MIX, Wt_out, MROWS, DM, DM}; pg8::StaticOrder S; S.init(MROWS, DM, G, blk);
        pg8::EpiResid E{p.x, p.out, U, PART};
        pg8::gemm_phase<pg8::EpiResid, pg8::StaticOrder, true, true>(lds, g, S, E);
    }
    GRID_SYNC(3);
    if (IN(4)) {
        pg8::Gemm g{U, Wt_up, MROWS, FF, DM}; pg8::StaticOrder S; S.init(MROWS, FF, G, blk);
        pg8::EpiUp E{PROJ, FF, PART};
        pg8::gemm_phase<pg8::EpiUp, pg8::StaticOrder, true, true>(lds, g, S, E);
    }
    GRID_SYNC(4);
    if (IN(5)) {
        pg8::Gemm g{PROJ, Wt_dn, MROWS, DM, FF}; pg8::StaticOrder S; S.init(MROWS, DM, G, blk);
        pg8::EpiDown E{p.out};
        pg8::gemm_phase<pg8::EpiDown, pg8::StaticOrder, true, true>(lds, g, S, E);
    }
#ifdef DUMP_BUF
    if (IN(6)) {
        const bf16_t* src = DUMP_BUF == 1 ? MIX : (DUMP_BUF == 2 ? U : PROJ); const int ld = DUMP_BUF == 3 ? 4096 : 1024;
        for (size_t i = (size_t)blk * NTHREADS + tid; i < (size_t)MROWS * DM; i += (size_t)G * NTHREADS) { const size_t r = i >> 10, c = i & 1023; p.out[i] = bf2f(src[r * ld + c]); }
    }
#endif
}

extern "C" void kernel_launch(void* const* d_in, const int* in_sizes, int n_in, void* d_out, int out_size, void* d_ws, size_t ws_size, hipStream_t stream) {
    static int grid_blocks = 0;
    if (grid_blocks == 0) {
        if (n_in != 13 || in_sizes[0] != MROWS * DM || out_size != MROWS * DM || ws_size < WS_END) {
            fprintf(stderr, "kernel_launch: unexpected shapes: n_in %d in0 %d out %d ws %zu (need %zu)\n", n_in, n_in > 0 ? in_sizes[0] : -1, out_size, ws_size, (size_t)WS_END); grid_blocks = -1; return; }
        int dev = 0, cus = 0, per_cu = 0;
        (void)hipGetDevice(&dev);
        (void)hipDeviceGetAttribute(&cus, hipDeviceAttributeMultiprocessorCount, dev);
        if (hipFuncSetAttribute((const void*)fwd_kernel, hipFuncAttributeMaxDynamicSharedMemorySize, LDS_BYTES) != hipSuccess) { fprintf(stderr, "kernel_launch: hipFuncSetAttribute failed\n"); grid_blocks = -1; return; }
        (void)hipOccupancyMaxActiveBlocksPerMultiprocessor(&per_cu, (const void*)fwd_kernel, NTHREADS, LDS_BYTES);
        if (per_cu < 1) { fprintf(stderr, "kernel_launch: occupancy query says %d blocks per CU\n", per_cu); per_cu = 1; }
        if (per_cu > 1) per_cu = 1;
        grid_blocks = cus * per_cu;
        (void)hipGetLastError();
    }
    if (grid_blocks < 0) return;
    Params p{};
    p.x = (const float*)d_in[0]; p.w_in = (const float*)d_in[1]; p.w_out = (const float*)d_in[2]; p.anw = (const float*)d_in[3]; p.mnw = (const float*)d_in[4];
    p.qnw = (const float*)d_in[5]; p.knw = (const float*)d_in[6]; p.rpb = (const float*)d_in[7]; p.hgw = (const float*)d_in[8]; p.lbf = (const float*)d_in[9]; p.lbb = (const float*)d_in[10];
    p.w_up = (const float*)d_in[11]; p.w_dn = (const float*)d_in[12]; p.out = (float*)d_out; p.ws = (unsigned char*)d_ws;
    if (MK_N_LAUNCHES == 1) {
        int lo = 0, hi = 6;
        void* args[] = {&p, &lo, &hi};
        hipError_t e = hipLaunchCooperativeKernel((const void*)fwd_kernel, dim3(grid_blocks), dim3(NTHREADS), args, LDS_BYTES, stream);
        if (e != hipSuccess) fprintf(stderr, "kernel_launch: cooperative launch failed: %s (grid %d)\n", hipGetErrorString(e), grid_blocks);
    } else {
#ifdef DUMP_BUF
        const int NPH = 7;
#else
        const int NPH = 6;
#endif
        for (int k = 0; k < NPH; ++k) hipLaunchKernelGGL(fwd_kernel, dim3(grid_blocks), dim3(NTHREADS), LDS_BYTES, stream, p, k, k + 1);
    }
}
```

```cpp
#include <hip/hip_runtime.h>
#include <hip/hip_cooperative_groups.h>
#include <cstdio>
#include <cstdint>
namespace cg = cooperative_groups;

#define LAS __attribute__((address_space(3)))
typedef unsigned short bf16_t;
typedef short bf16x8 __attribute__((ext_vector_type(8)));
typedef float f32x4 __attribute__((ext_vector_type(4)));
typedef float f32x2 __attribute__((ext_vector_type(2)));
typedef unsigned u32x4 __attribute__((ext_vector_type(4)));
typedef unsigned u32x2 __attribute__((ext_vector_type(2)));

constexpr int BATCH = 32, SEQ = 2048, DM = 1024, MROWS = BATCH * SEQ, DIN = 4096, FF = 4096;
constexpr float RMS_EPS = 1e-6f;
constexpr float LOG2E = 1.4426950408889634f;
constexpr int NTHREADS = 512, NWAVES = 8;
constexpr int LDS_BYTES = 155648;

constexpr size_t MiB = 1u << 20;
constexpr size_t WS_WIN = 2 * MiB, WS_WOUT = 10 * MiB, WS_WUP = 12 * MiB, WS_WDN = 20 * MiB, WS_PART = 28 * MiB;
constexpr size_t WS_U = 32 * MiB;
constexpr size_t WS_MIX = 160 * MiB;
constexpr size_t WS_PROJ = 288 * MiB;
constexpr size_t WS_OPART = 800 * MiB;
constexpr size_t WS_END = 928 * MiB;

typedef __bf16 hwbf16x2 __attribute__((ext_vector_type(2)));
__device__ __forceinline__ unsigned cvt_pk_bf16(float lo, float hi) { const f32x2 v = {lo, hi}; const hwbf16x2 b = __builtin_convertvector(v, hwbf16x2); return __builtin_bit_cast(unsigned, b); }
__device__ __forceinline__ float bf2f(unsigned short v) { return __uint_as_float(((unsigned)v) << 16); }
__device__ __forceinline__ float bflo(unsigned w) { return __uint_as_float(w << 16); }
__device__ __forceinline__ float bfhi(unsigned w) { return __uint_as_float(w & 0xffff0000u); }
__device__ __forceinline__ float wave_sum(float v) {
#pragma unroll
    for (int o = 1; o < 64; o <<= 1) v += __shfl_xor(v, o);
    return v;
}
__device__ __forceinline__ float wave_max(float v) {
#pragma unroll
    for (int o = 1; o < 64; o <<= 1) v = fmaxf(v, __shfl_xor(v, o));
    return v;
}

namespace pg8 {
#define PG8_LAS __attribute__((address_space(3)))
constexpr int BM = 256, BK = 64, HALF = 128, HTB = HALF * BK * 2, STAGE_BYTES = 8 * HTB, NXCD = 8, WGM = 8;

__host__ __device__ __forceinline__ int lds_byte(int r, int c) { const int st = (r >> 4) * 2 + (c >> 5), rr = r & 15, cc = c & 31, ob = rr * 64 + cc * 2; return st * 1024 + (ob ^ (((ob >> 9) & 1) << 5)); }
__host__ __device__ __forceinline__ void stage_rc(int b, int& R, int& C) { const int st = b / 1024, sb = b % 1024, swz = sb ^ (((sb >> 9) & 1) << 5); R = (st >> 1) * 16 + swz / 64; C = (st & 1) * 32 + (swz % 64) / 2; }
__host__ __device__ __forceinline__ int perm32(int rho) { const int n = rho >> 4, i = rho & 15; return 8 * (i >> 2) + 4 * n + (i & 3); }

struct Unit { int pm, pn; };
struct Gemm { const bf16_t* A; const bf16_t* Bt; int M, N, K; };

struct StaticOrder {
    int nM, nN, nwg, G, c;
    __host__ __device__ void init(int M, int N, int G_, int c_) { nM = M / BM; nN = N / BM; nwg = nM * nN; G = G_; c = c_; }
    __host__ __device__ bool next(int i, Unit& u) const {
        const long L = (long)i * G + c; if (L >= nwg) return false;
        int wgid = (int)L; { const int q = nwg / NXCD, r = nwg % NXCD, xcd = wgid % NXCD, off = wgid / NXCD; wgid = (xcd < r ? xcd * (q + 1) : r * (q + 1) + (xcd - r) * q) + off; }
        const int nig = WGM * nN, gid = wgid / nig, fm = gid * WGM, gsz = (nM - fm) < WGM ? (nM - fm) : WGM;
        u.pm = fm + ((wgid % nig) % gsz); u.pn = (wgid % nig) / gsz; return true;
    }
    __device__ __forceinline__ void a_ready(const Unit&) const {}
    __device__ __forceinline__ void done(const Unit&) const {}
};

struct EpiBf16 {
    static constexpr bool PERM = true, AFTER_DRAIN = false;
    bf16_t* O; int ldc;
    __device__ __forceinline__ void operator()(const f32x4 (&acc)[2][2][4][2], const Unit& u, int wr, int wc, int fr, int fq) const {
        const int row0 = u.pm * BM + wr * 64 + fr; const int col0 = u.pn * BM + wc * 32 + 8 * fq;
#pragma unroll
        for (int ai = 0; ai < 2; ++ai)
#pragma unroll
            for (int m = 0; m < 4; ++m) { bf16_t* rowp = O + (size_t)(row0 + ai * HALF + m * 16) * ldc + col0;
#pragma unroll
                for (int bj = 0; bj < 2; ++bj) { const f32x4 v0 = acc[ai][bj][m][0], v1 = acc[ai][bj][m][1];
                    u32x4 w; w.x = cvt_pk_bf16(v0[0], v0[1]); w.y = cvt_pk_bf16(v0[2], v0[3]); w.z = cvt_pk_bf16(v1[0], v1[1]); w.w = cvt_pk_bf16(v1[2], v1[3]);
                    *(u32x4*)(rowp + bj * HALF) = w; } }
    }
};
struct EpiUp {
    static constexpr bool PERM = true, AFTER_DRAIN = false;
    bf16_t* O; int ldc; const float* part;
    __device__ __forceinline__ void operator()(const f32x4 (&acc)[2][2][4][2], const Unit& u, int wr, int wc, int fr, int fq) const {
        const int row0 = u.pm * BM + wr * 64 + fr; const int col0 = u.pn * BM + wc * 32 + 8 * fq;
#pragma unroll
        for (int ai = 0; ai < 2; ++ai)
#pragma unroll
            for (int m = 0; m < 4; ++m) { const int row = row0 + ai * HALF + m * 16; bf16_t* rowp = O + (size_t)row * ldc + col0;
                const f32x4* pp = (const f32x4*)(part + (size_t)row * 16); const f32x4 s4 = (pp[0] + pp[1]) + (pp[2] + pp[3]);
                const float rs = rsqrtf(((s4[0] + s4[1]) + (s4[2] + s4[3])) * (1.0f / DM) + RMS_EPS);
#pragma unroll
                for (int bj = 0; bj < 2; ++bj) { f32x4 v0 = acc[ai][bj][m][0] * rs, v1 = acc[ai][bj][m][1] * rs;
#pragma unroll
                    for (int e = 0; e < 4; ++e) { const float a = fmaxf(v0[e], 0.f), b = fmaxf(v1[e], 0.f); v0[e] = a * a; v1[e] = b * b; }
                    u32x4 w; w.x = cvt_pk_bf16(v0[0], v0[1]); w.y = cvt_pk_bf16(v0[2], v0[3]); w.z = cvt_pk_bf16(v1[0], v1[1]); w.w = cvt_pk_bf16(v1[2], v1[3]);
                    *(u32x4*)(rowp + bj * HALF) = w; } }
    }
};
struct EpiResid {
    static constexpr bool PERM = false, AFTER_DRAIN = false;
    const float* x; float* out; bf16_t* hb; float* part;
    __device__ __forceinline__ void operator()(const f32x4 (&acc)[2][2][4][2], const Unit& u, int wr, int wc, int fr, int fq) const {
        const int col0 = u.pn * BM + wc * 32 + 4 * fq;
#pragma unroll
        for (int ai = 0; ai < 2; ++ai)
#pragma unroll
            for (int m = 0; m < 4; ++m) { const int row = u.pm * BM + ai * HALF + wr * 64 + m * 16 + fr; const size_t off = (size_t)row * DM + col0; float ss = 0.f;
#pragma unroll
                for (int bj = 0; bj < 2; ++bj)
#pragma unroll
                    for (int n = 0; n < 2; ++n) { const size_t c = off + bj * HALF + n * 16; const f32x4 hv = *(const f32x4*)(x + c) + acc[ai][bj][m][n];
                        *(f32x4*)(out + c) = hv; ss += (hv[0] * hv[0] + hv[1] * hv[1]) + (hv[2] * hv[2] + hv[3] * hv[3]);
                        u32x2 w; w.x = cvt_pk_bf16(hv[0], hv[1]); w.y = cvt_pk_bf16(hv[2], hv[3]); *(u32x2*)(hb + c) = w; }
                ss += __shfl_xor(ss, 16); ss += __shfl_xor(ss, 32);
                if (fq == 0) part[(size_t)row * 16 + u.pn * 4 + wc] = ss; }
    }
};
struct EpiDown {
    static constexpr bool PERM = false, AFTER_DRAIN = false;
    float* out;
    __device__ __forceinline__ void operator()(const f32x4 (&acc)[2][2][4][2], const Unit& u, int wr, int wc, int fr, int fq) const {
        const int col0 = u.pn * BM + wc * 32 + 4 * fq;
#pragma unroll
        for (int ai = 0; ai < 2; ++ai)
#pragma unroll
            for (int m = 0; m < 4; ++m) { const int row = u.pm * BM + ai * HALF + wr * 64 + m * 16 + fr; const size_t off = (size_t)row * DM + col0;
#pragma unroll
                for (int bj = 0; bj < 2; ++bj)
#pragma unroll
                    for (int n = 0; n < 2; ++n) { const size_t c = off + bj * HALF + n * 16; *(f32x4*)(out + c) = *(const f32x4*)(out + c) + acc[ai][bj][m][n]; } }
    }
};

template <class Epi, class Sched, bool ALIGN_EPI = false, bool SP2 = false>
__device__ __forceinline__ void gemm_phase(PG8_LAS unsigned char* lds, const Gemm g, const Sched& S, const Epi& E) {
    const int tid = threadIdx.x, wid = __builtin_amdgcn_readfirstlane(tid >> 6), lane = tid & 63, wr = wid >> 2, wc = wid & 3, fr = lane & 15, fq = lane >> 4;
    const int K = g.K, nt = K / BK;
    unsigned voffA[2], voffB[2];
#pragma unroll
    for (int i = 0; i < 2; ++i) { int R, C; stage_rc(tid * 16 + i * 8192, R, C); const int Rb = Epi::PERM ? ((R & ~31) + perm32(R & 31)) : R;
        voffA[i] = (unsigned)(R * K + C) * 2u; voffB[i] = (unsigned)(Rb * K + C) * 2u; }
    const size_t kstep = (size_t)(BK * 2);
    const size_t hstep = (size_t)HALF * K * 2;
    const size_t tstep = 2 * hstep;
    const unsigned ldsw = (unsigned)wid * 1024u;
    const int aoff = lds_byte(wr * 64 + fr, fq * 8), boff = lds_byte(wc * 32 + fr, fq * 8);
#define PG8_SA(b, h) (((b) * 2 + (h)) * HTB)
#define PG8_SB(b, h) ((4 + (b) * 2 + (h)) * HTB)
#define PG8_STAGE(bufoff, gbase, voff) do { _Pragma("unroll") for (int _i = 0; _i < 2; ++_i) \
        __builtin_amdgcn_global_load_lds((const unsigned*)((const char*)(gbase) + (voff)[_i]), (PG8_LAS unsigned*)(lds + (bufoff) + ldsw + _i * 8192), 16, 0, 0); } while (0)
#define PG8_LDA(dst, b, h) do { _Pragma("unroll") for (int m = 0; m < 4; ++m) _Pragma("unroll") for (int k = 0; k < 2; ++k) dst[m][k] = *(const PG8_LAS bf16x8*)(lds + PG8_SA(b, h) + aoff + m * 2048 + k * 1024); } while (0)
#define PG8_LDB(dst, b, h) do { _Pragma("unroll") for (int n = 0; n < 2; ++n) _Pragma("unroll") for (int k = 0; k < 2; ++k) dst[n][k] = *(const PG8_LAS bf16x8*)(lds + PG8_SB(b, h) + boff + n * 2048 + k * 1024); } while (0)
#define PG8_MMA(ai, bj, At, Bt) do { __builtin_amdgcn_s_setprio(1); _Pragma("unroll") for (int m = 0; m < 4; ++m) _Pragma("unroll") for (int n = 0; n < 2; ++n) _Pragma("unroll") for (int k = 0; k < 2; ++k) \
        acc[ai][bj][m][n] = __builtin_amdgcn_mfma_f32_16x16x32_bf16(Bt[n][k], At[m][k], acc[ai][bj][m][n], 0, 0, 0); __builtin_amdgcn_s_setprio(0); } while (0)
#define PG8_WAIT_V(n) asm volatile("s_waitcnt vmcnt(" #n ")" ::: "memory")
#define PG8_WAIT_L(n) asm volatile("s_waitcnt lgkmcnt(" #n ")" ::: "memory")
#define PG8_BAR __builtin_amdgcn_s_barrier()
#define PG8_SCHED __builtin_amdgcn_sched_barrier(0)
    Unit cur, nxt; int ui = 0;
    if (!S.next(0, cur)) return;
    f32x4 acc[2][2][4][2];
#pragma unroll
    for (int a = 0; a < 2; ++a)
#pragma unroll
        for (int b = 0; b < 2; ++b)
#pragma unroll
            for (int m = 0; m < 4; ++m)
#pragma unroll
                for (int n = 0; n < 2; ++n) acc[a][b][m][n] = (f32x4){0.f, 0.f, 0.f, 0.f};
    bf16x8 At[4][2], B0[2][2], B1[2][2];
    const char* cA = (const char*)g.A + (size_t)cur.pm * tstep; const char* cB = (const char*)g.Bt + (size_t)cur.pn * tstep;
    S.a_ready(cur);
    if constexpr (SP2) {
        PG8_STAGE(PG8_SB(0, 0), cB, voffB); PG8_STAGE(PG8_SB(0, 1), cB + hstep, voffB); PG8_STAGE(PG8_SA(0, 0), cA, voffA); PG8_STAGE(PG8_SA(0, 1), cA + hstep, voffA);
        if (wr == 1) PG8_BAR;
        PG8_WAIT_V(2); PG8_BAR;
        PG8_STAGE(PG8_SB(1, 0), cB + kstep, voffB); PG8_STAGE(PG8_SA(1, 0), cA + kstep, voffA); PG8_STAGE(PG8_SB(1, 1), cB + hstep + kstep, voffB);
        PG8_WAIT_V(6); PG8_BAR;
    } else {
        PG8_STAGE(PG8_SB(0, 0), cB, voffB); PG8_STAGE(PG8_SA(0, 0), cA, voffA); PG8_STAGE(PG8_SB(0, 1), cB + hstep, voffB); PG8_STAGE(PG8_SA(0, 1), cA + hstep, voffA);
        if (wr == 1) PG8_BAR;
        PG8_WAIT_V(4); PG8_BAR;
        PG8_STAGE(PG8_SB(1, 0), cB + kstep, voffB); PG8_STAGE(PG8_SA(1, 0), cA + kstep, voffA); PG8_STAGE(PG8_SB(1, 1), cB + hstep + kstep, voffB);
        PG8_WAIT_V(6); PG8_BAR;
    }
    for (;;) {
        const bool has_next = S.next(ui + 1, nxt);
        const char* nA = has_next ? (const char*)g.A + (size_t)nxt.pm * tstep : cA; const char* nB = has_next ? (const char*)g.Bt + (size_t)nxt.pn * tstep : cB;
        for (int t = 0; t < nt; t += 2) {
            const bool last = (t == nt - 2);
            const char* a1 = cA + (size_t)(t + 1) * kstep;
            const char* a2 = last ? nA : cA + (size_t)(t + 2) * kstep; const char* b2 = last ? nB : cB + (size_t)(t + 2) * kstep;
            const char* a3 = a2 + kstep; const char* b3 = b2 + kstep;
            if (last && has_next) S.a_ready(nxt);
            if constexpr (SP2) {
            PG8_LDB(B0, 0, 0); PG8_LDB(B1, 0, 1); PG8_SCHED; PG8_LDA(At, 0, 0); PG8_STAGE(PG8_SA(1, 1), a1 + hstep, voffA);
            PG8_WAIT_V(8); PG8_WAIT_L(0); PG8_BAR; PG8_MMA(0, 0, At, B0); PG8_MMA(0, 1, At, B1); PG8_BAR; PG8_SCHED;
            PG8_LDA(At, 0, 1); PG8_STAGE(PG8_SB(0, 0), b2, voffB); PG8_STAGE(PG8_SB(0, 1), b2 + hstep, voffB); PG8_STAGE(PG8_SA(0, 0), a2, voffA);
            PG8_WAIT_V(8); PG8_WAIT_L(0); PG8_BAR; PG8_MMA(1, 0, At, B0); PG8_MMA(1, 1, At, B1); PG8_BAR; PG8_SCHED;
            PG8_LDB(B0, 1, 0); PG8_LDB(B1, 1, 1); PG8_SCHED; PG8_LDA(At, 1, 0); PG8_STAGE(PG8_SA(0, 1), a2 + hstep, voffA);
            PG8_WAIT_V(8); PG8_WAIT_L(0); PG8_BAR; PG8_MMA(0, 0, At, B0); PG8_MMA(0, 1, At, B1); PG8_BAR; PG8_SCHED;
            PG8_LDA(At, 1, 1); PG8_STAGE(PG8_SB(1, 0), b3, voffB); PG8_STAGE(PG8_SB(1, 1), b3 + hstep, voffB); PG8_STAGE(PG8_SA(1, 0), a3, voffA);
            PG8_WAIT_V(8); PG8_WAIT_L(0); PG8_BAR; PG8_MMA(1, 0, At, B0); PG8_MMA(1, 1, At, B1); PG8_BAR; PG8_SCHED;
            } else {
            PG8_LDB(B0, 0, 0); PG8_SCHED; PG8_LDA(At, 0, 0); PG8_STAGE(PG8_SA(1, 1), a1 + hstep, voffA);
            PG8_WAIT_L(8); PG8_BAR; PG8_WAIT_L(0); PG8_MMA(0, 0, At, B0); PG8_BAR; PG8_SCHED;
            PG8_LDB(B1, 0, 1); PG8_STAGE(PG8_SB(0, 0), b2, voffB);
            PG8_BAR; PG8_WAIT_L(0); PG8_MMA(0, 1, At, B1); PG8_BAR;
            PG8_LDA(At, 0, 1); PG8_STAGE(PG8_SA(0, 0), a2, voffA);
            PG8_BAR; PG8_WAIT_L(0); PG8_MMA(1, 0, At, B0); PG8_BAR; PG8_SCHED;
            PG8_STAGE(PG8_SB(0, 1), b2 + hstep, voffB);
            PG8_WAIT_V(6); PG8_BAR; PG8_MMA(1, 1, At, B1); PG8_BAR;
            PG8_LDB(B0, 1, 0); PG8_SCHED; PG8_LDA(At, 1, 0); PG8_STAGE(PG8_SA(0, 1), a2 + hstep, voffA);
            PG8_WAIT_L(8); PG8_BAR; PG8_WAIT_L(0); PG8_MMA(0, 0, At, B0); PG8_BAR; PG8_SCHED;
            PG8_LDB(B1, 1, 1); PG8_STAGE(PG8_SB(1, 0), b3, voffB);
            PG8_BAR; PG8_WAIT_L(0); PG8_MMA(0, 1, At, B1); PG8_BAR;
            PG8_LDA(At, 1, 1); PG8_STAGE(PG8_SA(1, 0), a3, voffA);
            PG8_BAR; PG8_WAIT_L(0); PG8_MMA(1, 0, At, B0); PG8_BAR; PG8_SCHED;
            PG8_STAGE(PG8_SB(1, 1), b3 + hstep, voffB);
            PG8_WAIT_V(6); PG8_BAR; PG8_MMA(1, 1, At, B1); PG8_BAR;
            }
        }
        if constexpr (ALIGN_EPI) { if (wr == 0) PG8_BAR; }
        if constexpr (!Epi::AFTER_DRAIN) { E(acc, cur, wr, wc, fr, fq); S.done(cur); }
        if (!has_next) break;
#pragma unroll
        for (int a = 0; a < 2; ++a)
#pragma unroll
            for (int b = 0; b < 2; ++b)
#pragma unroll
                for (int m = 0; m < 4; ++m)
#pragma unroll
                    for (int n = 0; n < 2; ++n) acc[a][b][m][n] = (f32x4){0.f, 0.f, 0.f, 0.f};
        cur = nxt; cA = nA; cB = nB; ++ui;
        if constexpr (ALIGN_EPI) { if (wr == 1) PG8_BAR; }
    }
    PG8_WAIT_V(0);
    if constexpr (!ALIGN_EPI) { if (wr == 0) PG8_BAR; }
    PG8_BAR;
#undef PG8_SA
#undef PG8_SB
#undef PG8_STAGE
#undef PG8_LDA
#undef PG8_LDB
#undef PG8_MMA
#undef PG8_WAIT_V
#undef PG8_WAIT_L
#undef PG8_BAR
#undef PG8_SCHED
}
}

struct Params {
    const float *x, *w_in, *w_out, *anw, *mnw, *qnw, *knw, *rpb, *hgw, *lbf, *lbb, *w_up, *w_dn;
    float* out; unsigned char* ws;
};

__device__ __forceinline__ void p0_transpose_item(const float* W, int K, int N, bf16_t* WT, const float* scale, LAS float* scr, int item, int lane) {
    const int nblk = N / 32, kb = item / nblk, nb = item % nblk, k0 = 64 * kb, n0 = 32 * nb;
#pragma unroll 8
    for (int i = 0; i < 32; ++i) { const int kk = 2 * i + (lane >> 5); float v = W[(size_t)(k0 + kk) * N + n0 + (lane & 31)]; if (scale) v *= scale[k0 + kk]; scr[kk * 33 + (lane & 31)] = v; }
    asm volatile("s_waitcnt lgkmcnt(0)" ::: "memory");
    const int c = lane & 7;
#pragma unroll
    for (int j = 0; j < 4; ++j) { const int n = (lane >> 3) + 8 * j; const LAS float* s = scr + (8 * c) * 33 + n;
        u32x4 o; o.x = cvt_pk_bf16(s[0 * 33], s[1 * 33]); o.y = cvt_pk_bf16(s[2 * 33], s[3 * 33]); o.z = cvt_pk_bf16(s[4 * 33], s[5 * 33]); o.w = cvt_pk_bf16(s[6 * 33], s[7 * 33]);
        *(u32x4*)(WT + (size_t)(n0 + n) * K + k0 + 8 * c) = o; }
    asm volatile("s_waitcnt lgkmcnt(0)" ::: "memory");
}
__device__ __forceinline__ void rms_row_to_bf16(const float* xrow, const f32x4 (&wv)[4], bf16_t* orow, int lane) {
    const f32x4* xr = (const f32x4*)xrow + lane;
    f32x4 v[4]; float s = 0.f;
#pragma unroll
    for (int j = 0; j < 4; ++j) { v[j] = xr[64 * j]; s += (v[j].x * v[j].x + v[j].y * v[j].y) + (v[j].z * v[j].z + v[j].w * v[j].w); }
    const float rstd = rsqrtf(wave_sum(s) * (1.f / DM) + RMS_EPS);
    u32x2* o8 = (u32x2*)orow + lane;
#pragma unroll
    for (int j = 0; j < 4; ++j) { const f32x4 y = v[j] * rstd * wv[j]; u32x2 w; w.x = cvt_pk_bf16(y.x, y.y); w.y = cvt_pk_bf16(y.z, y.w); o8[64 * j] = w; }
}

namespace na {
constexpr int KR_OFF = 0;
constexpr int VT_OFF = 65536;
constexpr int VT_SLOT = 64 * 136;
constexpr int RPB_OFF = VT_OFF + 8 * VT_SLOT;
constexpr int MRG_OFF = RPB_OFF + 2048;
constexpr int END = MRG_OFF + 17408;
static_assert(END <= LDS_BYTES, "na lds");

__device__ __forceinline__ void na_item(LAS unsigned char* lds, const Params& p, const bf16_t* PROJ, bf16_t* MIX, int b, int h) {
    const int tid = threadIdx.x, w = __builtin_amdgcn_readfirstlane(tid >> 6), l = tid & 63;
    const int n = w & 3, half = w >> 2, q16 = l & 15, g = l >> 4;
    LAS float* RPB = (LAS float*)(lds + RPB_OFF);
    const float mq = wave_max(fabsf(p.qnw[l])), mk = wave_max(fabsf(p.knw[l]));
    float mr = 0.f;
    for (int i = l; i < 465; i += 64) mr = fmaxf(mr, fabsf(p.rpb[h * 465 + i]));
    mr = wave_max(mr);
    for (int i = tid; i < 465; i += NTHREADS) RPB[i] = p.rpb[h * 465 + i] * LOG2E;
    const float Mshift = (64.f * mq * mk * 0.125f + mr) * LOG2E;
    float qsw[2][8];
#pragma unroll
    for (int ks = 0; ks < 2; ++ks)
#pragma unroll
        for (int j = 0; j < 8; ++j) qsw[ks][j] = p.qnw[8 * g + 32 * ks + j] * (0.125f * LOG2E);
    const int lc = tid >> 3, ldg = tid & 7;
    float knw[8];
#pragma unroll
    for (int j = 0; j < 8; ++j) knw[j] = p.knw[ldg * 8 + j];
    const int lsw = (lc ^ (lc >> 3)) & 7;
    __syncthreads();
    const int c = 16 * n + q16;
    const int cs = min(max(c - 8, 0), 48), bs = min(max(16 * n - 8, 0), 32);
    int nl = 0;
    for (int r = 0; r < 32; ++r) {
        const int start = min(max(r - 4, 0), 24);
        while (nl < start + 8) {
            const int slot = nl & 7;
            const bf16_t* gp = PROJ + (size_t)(b * SEQ + nl * 64 + lc) * DIN + 512 + h * 64 + ldg * 8;
            const u32x4 kv = *(const u32x4*)gp, vv = *(const u32x4*)(gp + 512);
            float kf[8];
#pragma unroll
            for (int j = 0; j < 4; ++j) { kf[2 * j] = bflo(kv[j]); kf[2 * j + 1] = bfhi(kv[j]); }
            float ss = 0.f;
#pragma unroll
            for (int j = 0; j < 8; ++j) ss += kf[j] * kf[j];
            ss += __shfl_xor(ss, 1); ss += __shfl_xor(ss, 2); ss += __shfl_xor(ss, 4);
            const float rstd = rsqrtf(ss * (1.f / 64.f) + RMS_EPS);
            u32x4 ko;
#pragma unroll
            for (int j = 0; j < 4; ++j) ko[j] = cvt_pk_bf16(kf[2 * j] * rstd * knw[2 * j], kf[2 * j + 1] * rstd * knw[2 * j + 1]);
            *(LAS u32x4*)(lds + KR_OFF + slot * 8192 + lc * 128 + ((ldg ^ lsw) << 4)) = ko;
            LAS unsigned char* vb = lds + VT_OFF + slot * VT_SLOT + (ldg * 8) * 136 + lc * 2;
#pragma unroll
            for (int j = 0; j < 4; ++j) { *(LAS unsigned short*)(vb + (2 * j) * 136) = (unsigned short)(vv[j] & 0xffffu); *(LAS unsigned short*)(vb + (2 * j + 1) * 136) = (unsigned short)(vv[j] >> 16); }
            ++nl;
        }
        bf16x8 bq[2];
        {
            const bf16_t* qp = PROJ + (size_t)(b * SEQ + r * 64 + c) * DIN + h * 64 + 8 * g;
            const u32x4 q0 = *(const u32x4*)qp, q1 = *(const u32x4*)(qp + 32);
            float qf[2][8];
#pragma unroll
            for (int j = 0; j < 4; ++j) { qf[0][2 * j] = bflo(q0[j]); qf[0][2 * j + 1] = bfhi(q0[j]); qf[1][2 * j] = bflo(q1[j]); qf[1][2 * j + 1] = bfhi(q1[j]); }
            float ss = 0.f;
#pragma unroll
            for (int j = 0; j < 8; ++j) ss += qf[0][j] * qf[0][j] + qf[1][j] * qf[1][j];
            ss += __shfl_xor(ss, 16); ss += __shfl_xor(ss, 32);
            const float rstd = rsqrtf(ss * (1.f / 64.f) + RMS_EPS);
#pragma unroll
            for (int ks = 0; ks < 2; ++ks) { u32x4 t;
#pragma unroll
                for (int j = 0; j < 4; ++j) t[j] = cvt_pk_bf16(qf[ks][2 * j] * rstd * qsw[ks][2 * j], qf[ks][2 * j + 1] * rstd * qsw[ks][2 * j + 1]);
                bq[ks] = __builtin_bit_cast(bf16x8, t); }
        }
        __syncthreads();
        f32x4 o[4];
#pragma unroll
        for (int dt = 0; dt < 4; ++dt) o[dt] = (f32x4){0.f, 0.f, 0.f, 0.f};
        float lsum = 0.f;
#pragma unroll
        for (int krl = 0; krl < 4; ++krl) {
            const int R = start + 4 * half + krl, slot = R & 7, ridx = R - r + 7;
            const LAS unsigned char* kbase = lds + KR_OFF + slot * 8192;
            f32x4 s[2];
#pragma unroll
            for (int ct = 0; ct < 2; ++ct) {
                const int kcol = bs + 16 * ct + q16, sw = (kcol ^ (kcol >> 3)) & 7;
                const bf16x8 a0 = *(const LAS bf16x8*)(kbase + kcol * 128 + ((g ^ sw) << 4));
                const bf16x8 a1 = *(const LAS bf16x8*)(kbase + kcol * 128 + (((g + 4) ^ sw) << 4));
                f32x4 acc = (f32x4){0.f, 0.f, 0.f, 0.f};
                acc = __builtin_amdgcn_mfma_f32_16x16x32_bf16(a0, bq[0], acc, 0, 0, 0);
                acc = __builtin_amdgcn_mfma_f32_16x16x32_bf16(a1, bq[1], acc, 0, 0, 0);
                s[ct] = acc;
            }
            float pv[2][4];
#pragma unroll
            for (int ct = 0; ct < 2; ++ct)
#pragma unroll
                for (int i = 0; i < 4; ++i) {
                    const int kc = bs + 16 * ct + 4 * g + i; const bool valid = (unsigned)(kc - cs) < 16u;
                    const int idx = valid ? (ridx * 31 + (kc - c + 15)) : 0;
                    const float bias = RPB[idx];
                    const float e = __builtin_amdgcn_exp2f(s[ct][i] + bias - Mshift);
                    pv[ct][i] = valid ? e : 0.f; lsum += pv[ct][i];
                }
            u32x4 pw; pw.x = cvt_pk_bf16(pv[0][0], pv[0][1]); pw.y = cvt_pk_bf16(pv[0][2], pv[0][3]); pw.z = cvt_pk_bf16(pv[1][0], pv[1][1]); pw.w = cvt_pk_bf16(pv[1][2], pv[1][3]);
            const bf16x8 pb = __builtin_bit_cast(bf16x8, pw);
            const LAS unsigned char* vbase = lds + VT_OFF + slot * VT_SLOT + (bs + 4 * g) * 2;
#pragma unroll
            for (int dt = 0; dt < 4; ++dt) {
                const LAS unsigned char* va = vbase + (16 * dt + q16) * 136;
                const u32x2 lo = *(const LAS u32x2*)va, hi = *(const LAS u32x2*)(va + 32);
                u32x4 t; t.x = lo.x; t.y = lo.y; t.z = hi.x; t.w = hi.y;
                o[dt] = __builtin_amdgcn_mfma_f32_16x16x32_bf16(__builtin_bit_cast(bf16x8, t), pb, o[dt], 0, 0, 0);
            }
        }
        lsum += __shfl_xor(lsum, 16); lsum += __shfl_xor(lsum, 32);
        LAS float* mg = (LAS float*)(lds + MRG_OFF) + ((w & 3) * 64 + l) * 17;
        if (half == 1) {
#pragma unroll
            for (int dt = 0; dt < 4; ++dt)
#pragma unroll
                for (int i = 0; i < 4; ++i) mg[dt * 4 + i] = o[dt][i];
            mg[16] = lsum;
        }
        __syncthreads();
        if (half == 0) {
            const float inv = 1.0f / (lsum + mg[16]);
            bf16_t* op = MIX + (size_t)(b * SEQ + r * 64 + c) * DM + h * 64 + 4 * g;
#pragma unroll
            for (int dt = 0; dt < 4; ++dt) { u32x2 wv; wv.x = cvt_pk_bf16((o[dt][0] + mg[dt * 4 + 0]) * inv, (o[dt][1] + mg[dt * 4 + 1]) * inv);
                wv.y = cvt_pk_bf16((o[dt][2] + mg[dt * 4 + 2]) * inv, (o[dt][3] + mg[dt * 4 + 3]) * inv); *(u32x2*)(op + 16 * dt) = wv; }
        }
    }
    __syncthreads();
}
}

namespace hg {
constexpr int ST_OFF = 0;
constexpr int ST_DIR = 128 * 272;
constexpr int QB_OFF = 2 * ST_DIR;
constexpr int KB_OFF = QB_OFF + 17408;
constexpr int K2_OFF = KB_OFF + 17408;
constexpr int VT_OFF = K2_OFF + 18432;
constexpr int PT_OFF = VT_OFF + 18432;
constexpr int PL_OFF = PT_OFF + 4096;
constexpr int SS_OFF = PL_OFF + 512;
constexpr int GW_OFF = SS_OFF + 512;
constexpr int END = GW_OFF + 512;
static_assert(END <= LDS_BYTES, "hg lds");

struct HgPre { unsigned hf[8], q[8], v[8]; };
template <int DIR>
__device__ __forceinline__ void hg_prefetch(const bf16_t* PROJ, int b, int h4, int ch, HgPre& r) {
    const int tid = threadIdx.x, cp = tid & 63, ts = __builtin_amdgcn_readfirstlane(tid >> 6);
    const bf16_t* rowb = PROJ + ((size_t)b * SEQ + (size_t)ch * 64 + 8 * ts) * DIN + h4 * 128;
#pragma unroll
    for (int i = 0; i < 8; ++i) { const unsigned* r0 = (const unsigned*)(rowb + (size_t)i * DIN);
        r.hf[i] = r0[(DIR ? 1280 : 1024) + cp]; r.q[i] = r0[768 + cp]; r.v[i] = r0[1536 + cp]; }
}
template <int DIR>
__device__ __forceinline__ void hg_step(LAS unsigned char* lds, const Params& p, const bf16_t* PROJ, bf16_t* MIX, float* OPART, int b, int h4, int ch, bool fin, const f32x2 lb, f32x4 (&S)[8],
                                        const HgPre& cur, HgPre& nxt, int nch, bool has_next) {
    const int tid = threadIdx.x, w = __builtin_amdgcn_readfirstlane(tid >> 6), l = tid & 63, q16 = l & 15, g = l >> 4;
    const size_t tok0 = (size_t)b * SEQ + (size_t)ch * 64;
    const int d0 = 2 * l, ts = w;
    LAS float* PT = (LAS float*)(lds + PT_OFF); LAS float* PL = (LAS float*)(lds + PL_OFF); LAS float* SSx = (LAS float*)(lds + SS_OFF);
    const int tt = w & 3, vh = w >> 2;
    const size_t token = tok0 + 16 * tt + q16;
    bf16_t* op = (bf16_t*)OPART + token * 512 + h4 * 128 + 64 * vh + 4 * g;
    float f[2][8];
    {
        float tot0 = 1.f, tot1 = 1.f;
#pragma unroll
        for (int i = 0; i < 8; ++i) {
            const float e0 = __builtin_amdgcn_exp2f(-bflo(cur.hf[i]) * LOG2E), e1 = __builtin_amdgcn_exp2f(-bfhi(cur.hf[i]) * LOG2E);
            f[0][i] = lb.x + (1.f - lb.x) * __builtin_amdgcn_rcpf(1.f + e0); f[1][i] = lb.y + (1.f - lb.y) * __builtin_amdgcn_rcpf(1.f + e1);
            tot0 *= f[0][i]; tot1 *= f[1][i];
        }
        *(LAS f32x2*)(PT + ts * 128 + d0) = (f32x2){tot0, tot1};
        u32x4 v0, v1;
#pragma unroll
        for (int j = 0; j < 4; ++j) { v0[j] = __builtin_amdgcn_perm(cur.v[2 * j + 1], cur.v[2 * j], 0x05040100u); v1[j] = __builtin_amdgcn_perm(cur.v[2 * j + 1], cur.v[2 * j], 0x07060302u); }
        *(LAS u32x4*)(lds + VT_OFF + d0 * 144 + ts * 16) = v0; *(LAS u32x4*)(lds + VT_OFF + (d0 + 1) * 144 + ts * 16) = v1;
    }
    __syncthreads();
    {
        float pl0 = 1.f, pl1 = 1.f, ps0 = 1.f, ps1 = 1.f;
#pragma unroll
        for (int sg = 0; sg < 8; ++sg) { const f32x2 v = *(const LAS f32x2*)(PT + sg * 128 + d0); pl0 *= v.x; pl1 *= v.y; const bool before = DIR ? (sg > ts) : (sg < ts); ps0 *= before ? v.x : 1.f; ps1 *= before ? v.y : 1.f; }
        float P0 = ps0, P1 = ps1; float k20[8], k21[8];
        LAS unsigned char* qb = lds + QB_OFF + (8 * ts) * 272 + d0 * 2;
#pragma unroll
        for (int ii = 0; ii < 8; ++ii) { const int i = DIR ? 7 - ii : ii;
            P0 *= f[0][i]; P1 *= f[1][i];
            const float kip0 = (1.f - f[0][i]) * __builtin_amdgcn_rcpf(P0), kip1 = (1.f - f[1][i]) * __builtin_amdgcn_rcpf(P1);
            *(LAS unsigned*)(qb + i * 272) = cvt_pk_bf16(bflo(cur.q[i]) * P0, bfhi(cur.q[i]) * P1);
            *(LAS unsigned*)(qb + (KB_OFF - QB_OFF) + i * 272) = cvt_pk_bf16(kip0, kip1);
            k20[i] = kip0 * pl0; k21[i] = kip1 * pl1; }
        u32x4 k0, k1;
#pragma unroll
        for (int j = 0; j < 4; ++j) { k0[j] = cvt_pk_bf16(k20[2 * j], k20[2 * j + 1]); k1[j] = cvt_pk_bf16(k21[2 * j], k21[2 * j + 1]); }
        *(LAS u32x4*)(lds + K2_OFF + d0 * 144 + ts * 16) = k0; *(LAS u32x4*)(lds + K2_OFF + (d0 + 1) * 144 + ts * 16) = k1;
        if (ts == 0) *(LAS f32x2*)(PL + d0) = (f32x2){pl0, pl1};
    }
    __syncthreads();
    u32x2 gr[4], opv[4];
    if (fin) {
        const bf16_t* gp = PROJ + token * DIN + 3584 + h4 * 128 + 64 * vh + 4 * g;
#pragma unroll
        for (int vtl = 0; vtl < 4; ++vtl) { gr[vtl] = *(const u32x2*)(gp + 16 * vtl); opv[vtl] = *(const u32x2*)(op + 16 * vtl); }
    }
    if (has_next) hg_prefetch<1 - DIR>(PROJ, b, h4, nch, nxt);
    bf16x8 qbf[4];
#pragma unroll
    for (int ks = 0; ks < 4; ++ks) qbf[ks] = *(const LAS bf16x8*)(lds + QB_OFF + (16 * tt + q16) * 272 + (8 * g + 32 * ks) * 2);
    bf16x8 pa[2];
    {
        f32x4 at[4];
#pragma unroll
        for (int jt = 0; jt < 4; ++jt) {
            at[jt] = (f32x4){0.f, 0.f, 0.f, 0.f};
            const bool skip = DIR ? (jt < tt) : (jt > tt);
            if (!skip) {
                f32x4 acc = (f32x4){0.f, 0.f, 0.f, 0.f};
#pragma unroll
                for (int ks = 0; ks < 4; ++ks) { const bf16x8 a = *(const LAS bf16x8*)(lds + KB_OFF + (16 * jt + q16) * 272 + (8 * g + 32 * ks) * 2);
                    acc = __builtin_amdgcn_mfma_f32_16x16x32_bf16(a, qbf[ks], acc, 0, 0, 0); }
#pragma unroll
                for (int i = 0; i < 4; ++i) { const int j = 16 * jt + 4 * g + i, t = 16 * tt + q16; const bool keep = DIR ? (j >= t) : (j <= t); at[jt][i] = keep ? acc[i] : 0.f; }
            }
        }
#pragma unroll
        for (int kp = 0; kp < 2; ++kp) { u32x4 t; t.x = cvt_pk_bf16(at[2 * kp][0], at[2 * kp][1]); t.y = cvt_pk_bf16(at[2 * kp][2], at[2 * kp][3]);
            t.z = cvt_pk_bf16(at[2 * kp + 1][0], at[2 * kp + 1][1]); t.w = cvt_pk_bf16(at[2 * kp + 1][2], at[2 * kp + 1][3]); pa[kp] = __builtin_bit_cast(bf16x8, t); }
    }
    f32x4 ot[4];
#pragma unroll
    for (int vtl = 0; vtl < 4; ++vtl) {
        const int vrow = 16 * (4 * vh + vtl) + q16;
        f32x4 acc = (f32x4){0.f, 0.f, 0.f, 0.f};
#pragma unroll
        for (int ks = 0; ks < 4; ++ks) { const bf16x8 a = *(const LAS bf16x8*)(lds + ST_OFF + DIR * ST_DIR + vrow * 272 + (8 * g + 32 * ks) * 2);
            acc = __builtin_amdgcn_mfma_f32_16x16x32_bf16(a, qbf[ks], acc, 0, 0, 0); }
#pragma unroll
        for (int kp = 0; kp < 2; ++kp) { const LAS unsigned char* va = lds + VT_OFF + vrow * 144 + (32 * kp + 4 * g) * 2;
            const u32x2 lo = *(const LAS u32x2*)va, hi = *(const LAS u32x2*)(va + 32);
            u32x4 t; t.x = lo.x; t.y = lo.y; t.z = hi.x; t.w = hi.y;
            acc = __builtin_amdgcn_mfma_f32_16x16x32_bf16(__builtin_bit_cast(bf16x8, t), pa[kp], acc, 0, 0, 0); }
        ot[vtl] = acc;
    }
    {
        if (!fin) {
#pragma unroll
            for (int vtl = 0; vtl < 4; ++vtl) { u32x2 o2; o2.x = cvt_pk_bf16(ot[vtl][0], ot[vtl][1]); o2.y = cvt_pk_bf16(ot[vtl][2], ot[vtl][3]); *(u32x2*)(op + 16 * vtl) = o2; }
            __syncthreads();
        } else {
            float ss = 0.f;
#pragma unroll
            for (int vtl = 0; vtl < 4; ++vtl) {
                ot[vtl] += (f32x4){bflo(opv[vtl].x), bfhi(opv[vtl].x), bflo(opv[vtl].y), bfhi(opv[vtl].y)};
                ss += (ot[vtl][0] * ot[vtl][0] + ot[vtl][1] * ot[vtl][1]) + (ot[vtl][2] * ot[vtl][2] + ot[vtl][3] * ot[vtl][3]); }
            ss += __shfl_xor(ss, 16); ss += __shfl_xor(ss, 32);
            if (g == 0) SSx[vh * 64 + 16 * tt + q16] = ss;
            __syncthreads();
            const float rstd = rsqrtf((SSx[16 * tt + q16] + SSx[64 + 16 * tt + q16]) * (1.f / 128.f) + RMS_EPS);
            bf16_t* mp = MIX + token * DM + 512 + h4 * 128 + 64 * vh + 4 * g;
#pragma unroll
            for (int vtl = 0; vtl < 4; ++vtl) {
                const f32x4 wv = *(const LAS f32x4*)(lds + GW_OFF + (64 * vh + 4 * g + 16 * vtl) * 4);
                const float gv[4] = {bflo(gr[vtl].x), bfhi(gr[vtl].x), bflo(gr[vtl].y), bfhi(gr[vtl].y)}; float y[4];
#pragma unroll
                for (int i = 0; i < 4; ++i) { const float sg = gv[i] * __builtin_amdgcn_rcpf(1.f + __builtin_amdgcn_exp2f(-gv[i] * LOG2E)); y[i] = ot[vtl][i] * rstd * wv[i] * sg; }
                u32x2 o2; o2.x = cvt_pk_bf16(y[0], y[1]); o2.y = cvt_pk_bf16(y[2], y[3]); *(u32x2*)(mp + 16 * vtl) = o2;
            }
        }
    }
    {
        bf16x8 vb[2];
#pragma unroll
        for (int ks = 0; ks < 2; ++ks) vb[ks] = *(const LAS bf16x8*)(lds + VT_OFF + (16 * w + q16) * 144 + (8 * g + 32 * ks) * 2);
#pragma unroll
        for (int dt = 0; dt < 8; ++dt) {
            const f32x4 pl = *(const LAS f32x4*)(lds + PL_OFF + (16 * dt + 4 * g) * 4);
            f32x4 acc = S[dt] * pl;
#pragma unroll
            for (int ks = 0; ks < 2; ++ks) { const bf16x8 a = *(const LAS bf16x8*)(lds + K2_OFF + (16 * dt + q16) * 144 + (8 * g + 32 * ks) * 2);
                acc = __builtin_amdgcn_mfma_f32_16x16x32_bf16(a, vb[ks], acc, 0, 0, 0); }
            S[dt] = acc;
            u32x2 sv; sv.x = cvt_pk_bf16(acc[0], acc[1]); sv.y = cvt_pk_bf16(acc[2], acc[3]);
            *(LAS u32x2*)(lds + ST_OFF + DIR * ST_DIR + (16 * w + q16) * 272 + (16 * dt + 4 * g) * 2) = sv;
        }
    }
    __syncthreads();
}

__device__ __forceinline__ void hg_item(LAS unsigned char* lds, const Params& p, const bf16_t* PROJ, bf16_t* MIX, float* OPART, int b, int h4) {
    const int tid = threadIdx.x, d0 = 2 * (tid & 63);
    f32x2 lbF, lbB;
    lbF.x = 1.f / (1.f + __expf(p.lbf[512 + h4 * 128 + d0] - p.lbf[h4 * 128 + d0])); lbF.y = 1.f / (1.f + __expf(p.lbf[512 + h4 * 128 + d0 + 1] - p.lbf[h4 * 128 + d0 + 1]));
    lbB.x = 1.f / (1.f + __expf(p.lbb[512 + h4 * 128 + d0] - p.lbb[h4 * 128 + d0])); lbB.y = 1.f / (1.f + __expf(p.lbb[512 + h4 * 128 + d0 + 1] - p.lbb[h4 * 128 + d0 + 1]));
    if (tid < 128) ((LAS float*)(lds + GW_OFF))[tid] = p.hgw[tid];
    for (int i = tid; i < (2 * ST_DIR) / 4; i += NTHREADS) ((LAS unsigned*)(lds + ST_OFF))[i] = 0u;
    f32x4 Sf[8], Sb[8];
#pragma unroll
    for (int i = 0; i < 8; ++i) { Sf[i] = (f32x4){0.f, 0.f, 0.f, 0.f}; Sb[i] = (f32x4){0.f, 0.f, 0.f, 0.f}; }
    __syncthreads();
    HgPre ra, rb;
    hg_prefetch<0>(PROJ, b, h4, 0, ra);
    for (int c = 0; c < 32; ++c) {
        hg_step<0>(lds, p, PROJ, MIX, OPART, b, h4, c, c >= 16, lbF, Sf, ra, rb, 31 - c, true);
        hg_step<1>(lds, p, PROJ, MIX, OPART, b, h4, 31 - c, c >= 16, lbB, Sb, rb, ra, c + 1, c + 1 < 32);
    }
}
}

#define GRID_SYNC(k) do { if (IN(k) && IN((k) + 1)) { asm volatile("s_waitcnt vmcnt(0) lgkmcnt(0)" ::: "memory"); __syncthreads(); grid.sync(); } } while (0)
#define IN(k) (ph_lo <= (k) && (k) < ph_hi)
#ifndef MK_N_LAUNCHES
#define MK_N_LAUNCHES 1
#endif
__global__ void __launch_bounds__(NTHREADS, 2) fwd_kernel(Params p, int ph_lo, int ph_hi) {
    extern __shared__ __attribute__((aligned(16))) unsigned char lds_raw[];
    LAS unsigned char* lds = (LAS unsigned char*)lds_raw;
    cg::grid_group grid = cg::this_grid();
    const int tid = threadIdx.x, lane = tid & 63, wave = __builtin_amdgcn_readfirstlane(tid >> 6);
    const int G = gridDim.x, blk = blockIdx.x;
    unsigned char* ws = p.ws;
    bf16_t* Wt_in = (bf16_t*)(ws + WS_WIN); bf16_t* Wt_out = (bf16_t*)(ws + WS_WOUT); bf16_t* Wt_up = (bf16_t*)(ws + WS_WUP); bf16_t* Wt_dn = (bf16_t*)(ws + WS_WDN);
    float* PART = (float*)(ws + WS_PART); bf16_t* U = (bf16_t*)(ws + WS_U); bf16_t* MIX = (bf16_t*)(ws + WS_MIX); bf16_t* PROJ = (bf16_t*)(ws + WS_PROJ); float* OPART = (float*)(ws + WS_OPART);

    if (IN(0)) {
        LAS float* scr = (LAS float*)(lds + wave * 16384);
        const int gw = blk * NWAVES + wave, NGW = G * NWAVES;
        constexpr int I_IN = (DM / 64) * (DIN / 32), I_OUT = (DM / 64) * (DM / 32), I_UP = (DM / 64) * (FF / 32), I_DN = (FF / 64) * (DM / 32);
        constexpr int NITEMS = I_IN + I_OUT + I_UP + I_DN;
        for (int it = gw; it < NITEMS; it += NGW) {
            int r = it;
            if (r < I_IN) { p0_transpose_item(p.w_in, DM, DIN, Wt_in, nullptr, scr, r, lane); continue; } r -= I_IN;
            if (r < I_OUT) { p0_transpose_item(p.w_out, DM, DM, Wt_out, nullptr, scr, r, lane); continue; } r -= I_OUT;
            if (r < I_UP) { p0_transpose_item(p.w_up, DM, FF, Wt_up, p.mnw, scr, r, lane); continue; } r -= I_UP;
            p0_transpose_item(p.w_dn, FF, DM, Wt_dn, nullptr, scr, r, lane);
        }
        f32x4 wv[4];
#pragma unroll
        for (int j = 0; j < 4; ++j) wv[j] = ((const f32x4*)p.anw)[lane + 64 * j];
        for (int m = gw; m < MROWS; m += NGW) rms_row_to_bf16(p.x + (size_t)m * DM, wv, U + (size_t)m * DM, lane);
#ifdef P0_FILL_MIX
        for (int m = gw; m < MROWS; m += NGW) { u32x4 c4; c4.x = c4.y = c4.z = c4.w = 0x3e803e80u; *((u32x4*)(MIX + (size_t)m * DM + 512) + lane) = c4; }
#endif
    }
    GRID_SYNC(0);
    if (IN(1)) {
        pg8::Gemm g{U, Wt_in, MROWS, DIN, DM}; pg8::StaticOrder S; S.init(MROWS, DIN, G, blk);
        pg8::EpiBf16 E{PROJ, DIN};
        pg8::gemm_phase<pg8::EpiBf16, pg8::StaticOrder, true, true>(lds, g, S, E);
    }
    GRID_SYNC(1);
#ifndef REPEAT_P2
#define REPEAT_P2 1
#endif
    if (IN(2)) for (int rep = 0; rep < REPEAT_P2; ++rep) {
        if (rep) { asm volatile("s_waitcnt vmcnt(0) lgkmcnt(0)" ::: "memory"); __syncthreads(); grid.sync(); }
        const int GH = G / 2;
#ifndef SKIP_HG
        if (blk < GH) { for (int it = blk; it < BATCH * 4; it += GH) hg::hg_item(lds, p, PROJ, MIX, OPART, it >> 2, it & 3); }
#endif
#ifndef SKIP_NA
        if (blk >= GH) { for (int it = blk - GH; it < BATCH * 8; it += G - GH) na::na_item(lds, p, PROJ, MIX, it >> 3, it & 7); }
#endif
    }
    GRID_SYNC(2);
    if (IN(3)) {
        pg8::Gemm g{MIX, Wt_out, MROWS, DM, DM}; pg8::StaticOrder S; S.init(MROWS, DM, G, blk);
        pg8::EpiResid E{p.x, p.out, U, PART};
        pg8::gemm_phase<pg8::EpiResid, pg8::StaticOrder, true, true>(lds, g, S, E);
    }
    GRID_SYNC(3);
    if (IN(4)) {
        pg8::Gemm g{U, Wt_up, MROWS, FF, DM}; pg8::StaticOrder S; S.init(MROWS, FF, G, blk);
        pg8::EpiUp E{PROJ, FF, PART};
        pg8::gemm_phase<pg8::EpiUp, pg8::StaticOrder, true, true>(lds, g, S, E);
    }
    GRID_SYNC(4);
    if (IN(5)) {
        pg8::Gemm g{PROJ, Wt_dn, MROWS, DM, FF}; pg8::StaticOrder S; S.init(MROWS, DM, G, blk);
        pg8::EpiDown E{p.out};
        pg8::gemm_phase<pg8::EpiDown, pg8::StaticOrder, true, true>(lds, g, S, E);
    }
#ifdef DUMP_BUF
    if (IN(6)) {
        const bf16_t* src = DUMP_BUF == 1 ? MIX : (DUMP_BUF == 2 ? U : PROJ); const int ld = DUMP_BUF == 3 ? 4096 : 1024;
        for (size_t i = (size_t)blk * NTHREADS + tid; i < (size_t)MROWS * DM; i += (size_t)G * NTHREADS) { const size_t r = i >> 10, c = i & 1023; p.out[i] = bf2f(src[r * ld + c]); }
    }
#endif
}

extern "C" void kernel_launch(void* const* d_in, const int* in_sizes, int n_in, void* d_out, int out_size, void* d_ws, size_t ws_size, hipStream_t stream) {
    static int grid_blocks = 0;
    if (grid_blocks == 0) {
        if (n_in != 13 || in_sizes[0] != MROWS * DM || out_size != MROWS * DM || ws_size < WS_END) {
            fprintf(stderr, "kernel_launch: unexpected shapes: n_in %d in0 %d out %d ws %zu (need %zu)\n", n_in, n_in > 0 ? in_sizes[0] : -1, out_size, ws_size, (size_t)WS_END); grid_blocks = -1; return; }
        int dev = 0, cus = 0, per_cu = 0;
        (void)hipGetDevice(&dev);
        (void)hipDeviceGetAttribute(&cus, hipDeviceAttributeMultiprocessorCount, dev);
        if (hipFuncSetAttribute((const void*)fwd_kernel, hipFuncAttributeMaxDynamicSharedMemorySize, LDS_BYTES) != hipSuccess) { fprintf(stderr, "kernel_launch: hipFuncSetAttribute failed\n"); grid_blocks = -1; return; }
        (void)hipOccupancyMaxActiveBlocksPerMultiprocessor(&per_cu, (const void*)fwd_kernel, NTHREADS, LDS_BYTES);
        if (per_cu < 1) { fprintf(stderr, "kernel_launch: occupancy query says %d blocks per CU\n", per_cu); per_cu = 1; }
        if (per_cu > 1) per_cu = 1;
        grid_blocks = cus * per_cu;
        (void)hipGetLastError();
    }
    if (grid_blocks < 0) return;
    Params p{};
    p.x = (const float*)d_in[0]; p.w_in = (const float*)d_in[1]; p.w_out = (const float*)d_in[2]; p.anw = (const float*)d_in[3]; p.mnw = (const float*)d_in[4];
    p.qnw = (const float*)d_in[5]; p.knw = (const float*)d_in[6]; p.rpb = (const float*)d_in[7]; p.hgw = (const float*)d_in[8]; p.lbf = (const float*)d_in[9]; p.lbb = (const float*)d_in[10];
    p.w_up = (const float*)d_in[11]; p.w_dn = (const float*)d_in[12]; p.out = (float*)d_out; p.ws = (unsigned char*)d_ws;
    if (MK_N_LAUNCHES == 1) {
        int lo = 0, hi = 6;
        void* args[] = {&p, &lo, &hi};
        hipError_t e = hipLaunchCooperativeKernel((const void*)fwd_kernel, dim3(grid_blocks), dim3(NTHREADS), args, LDS_BYTES, stream);
        if (e != hipSuccess) fprintf(stderr, "kernel_launch: cooperative launch failed: %s (grid %d)\n", hipGetErrorString(e), grid_blocks);
    } else {
#ifdef DUMP_BUF
        const int NPH = 7;
#else
        const int NPH = 6;
#endif
        for (int k = 0; k < NPH; ++k) hipLaunchKernelGGL(fwd_kernel, dim3(grid_blocks), dim3(NTHREADS), LDS_BYTES, stream, p, k, k + 1);
    }
}
```
